# Optimizing an MI355X kernel written in HIP

```python
import jax, jax.numpy as jnp
from jax import lax
import numpy as np

D_MODEL = 1024
BATCH = 8
SEQ = 4096
DEPTH = 1

CHUNK = 64
N_MEM = 256
NORM_EPS = 1e-6
SSD_WIDTH = D_MODEL
SSD_HEAD_DIM = 64
SSD_HEADS = SSD_WIDTH // SSD_HEAD_DIM
SSD_GROUPS = 4
SSD_STATE = 128
SSD_CONV = 4
SSD_CONV_DIM = SSD_WIDTH + 2 * SSD_GROUPS * SSD_STATE
LRU_WIDTH = D_MODEL
LRU_BLOCKS = 16
LRU_BLOCK_W = LRU_WIDTH // LRU_BLOCKS
LRU_CONV = 4
RG_C = 8.0
MIX_WIDTH = SSD_WIDTH + LRU_WIDTH
IN_PROJ = SSD_WIDTH + SSD_CONV_DIM + SSD_HEADS + 2 * LRU_WIDTH
X_HEADS = 4
X_HEAD_DIM = D_MODEL // X_HEADS
N_EXPERTS = 32
TOP_K = 4
D_FF = D_MODEL
SWIGLU_LIMIT = 7.0
SWIGLU_ALPHA = 1.702
MOE_BLOCK = 128

kernel_name = 'hybrid_ssd_rglru_memxattn_moe'


def rmsnorm(x, g):
    xf = x.astype(jnp.float32)
    y = xf * lax.rsqrt(jnp.mean(xf * xf, axis=-1, keepdims=True) + NORM_EPS)
    return (y * g.astype(jnp.float32)).astype(x.dtype)


def gated_rmsnorm(y, z, g):
    b, s, w = y.shape
    u = (y * jax.nn.silu(z)).astype(jnp.float32).reshape(b, s, SSD_GROUPS, w // SSD_GROUPS)
    u = u * lax.rsqrt(jnp.mean(u * u, axis=-1, keepdims=True) + NORM_EPS)
    return (u.reshape(b, s, w) * g.astype(jnp.float32)).astype(y.dtype)


def causal_dwconv(x, w, bias):
    k, c = w.shape
    y = lax.conv_general_dilated(x, w[:, None, :], window_strides=(1,), padding=[(k - 1, 0)],
                                 dimension_numbers=('NWC', 'WIO', 'NWC'), feature_group_count=c)
    return y + bias


def ssd_chunked(xh, dt, a, bm, cm):
    b, s, h, p = xh.shape
    g, n = bm.shape[2], bm.shape[3]
    k = h // g
    c = s // CHUNK
    xdt = (xh * dt[..., None]).reshape(b, c, CHUNK, g, k, p)
    a_cs = jnp.cumsum((dt * a).reshape(b, c, CHUNK, g, k), axis=2)
    bc = bm.reshape(b, c, CHUNK, g, n)
    cc = cm.reshape(b, c, CHUNK, g, n)
    causal = jnp.tril(jnp.ones((CHUNK, CHUNK), dtype=bool))[None, None, :, :, None, None]
    seg = a_cs[:, :, :, None] - a_cs[:, :, None, :]
    decay = jnp.exp(jnp.where(causal, seg, -jnp.inf))
    cb = jnp.einsum('bclgn,bcsgn->bclsg', cc, bc)
    y_diag = jnp.einsum('bclsgk,bcsgkp->bclgkp', cb[..., None] * decay, xdt)
    decay_end = jnp.exp(a_cs[:, :, -1:] - a_cs)
    states = jnp.einsum('bclgn,bclgkp->bcgkpn', bc, decay_end[..., None] * xdt)
    chunk_decay = jnp.exp(a_cs[:, :, -1])

    def step(hs, inp):
        dec, st = inp
        return dec[..., None, None] * hs + st, hs

    _, prev = lax.scan(step, jnp.zeros_like(states[:, 0]),
                       (jnp.moveaxis(chunk_decay, 1, 0), jnp.moveaxis(states, 1, 0)))
    prev = jnp.moveaxis(prev, 0, 1)
    y_off = jnp.einsum('bclgn,bcgkpn->bclgkp', cc, prev) * jnp.exp(a_cs)[..., None]
    return (y_diag + y_off).reshape(b, s, h, p)


def rg_lru(xr, wa, ba, wx, bx, lam):
    b, s, w = xr.shape
    nb, bw, _ = wa.shape
    xb = xr.reshape(b, s, nb, bw)
    r = jax.nn.sigmoid(jnp.einsum('bsni,nij->bsnj', xb, wa).reshape(b, s, w) + ba)
    i = jax.nn.sigmoid(jnp.einsum('bsni,nij->bsnj', xb, wx).reshape(b, s, w) + bx)
    log_a = -RG_C * r * jax.nn.softplus(-lam)
    a = jnp.exp(log_a)
    u = xr * i * jnp.sqrt(-jnp.expm1(2.0 * log_a))

    def combine(left, right):
        a1, b1 = left
        a2, b2 = right
        return a1 * a2, a2 * b1 + b2

    _, hs = lax.associative_scan(combine, (a, u), axis=1)
    return hs


def hybrid_mixer(hn, w_in, ssd_conv_w, ssd_conv_b, ssd_dt_bias, ssd_a_log, ssd_d, ssd_norm,
                 lru_conv_w, lru_conv_b, lru_wa, lru_ba, lru_wx, lru_bx, lru_lambda, w_out):
    b, s, _ = hn.shape
    proj = hn @ w_in
    o1 = SSD_WIDTH
    o2 = o1 + SSD_CONV_DIM
    o3 = o2 + SSD_HEADS
    o4 = o3 + LRU_WIDTH
    z, xbc, dt_raw, xr, gr = proj[..., :o1], proj[..., o1:o2], proj[..., o2:o3], proj[..., o3:o4], proj[..., o4:]
    xbc = jax.nn.silu(causal_dwconv(xbc, ssd_conv_w, ssd_conv_b)).astype(jnp.float32)
    nbc = SSD_GROUPS * SSD_STATE
    xs = xbc[..., :SSD_WIDTH].reshape(b, s, SSD_HEADS, SSD_HEAD_DIM)
    bm = xbc[..., SSD_WIDTH:SSD_WIDTH + nbc].reshape(b, s, SSD_GROUPS, SSD_STATE)
    cm = xbc[..., SSD_WIDTH + nbc:].reshape(b, s, SSD_GROUPS, SSD_STATE)
    dt = jax.nn.softplus(dt_raw.astype(jnp.float32) + ssd_dt_bias.astype(jnp.float32))
    a = -jnp.exp(ssd_a_log.astype(jnp.float32))
    y = ssd_chunked(xs, dt, a, bm, cm) + xs * ssd_d.astype(jnp.float32)[:, None]
    y_ssd = gated_rmsnorm(y.reshape(b, s, SSD_WIDTH).astype(hn.dtype), z, ssd_norm)
    xr = causal_dwconv(xr, lru_conv_w, lru_conv_b).astype(jnp.float32)
    hl = rg_lru(xr, lru_wa.astype(jnp.float32), lru_ba.astype(jnp.float32), lru_wx.astype(jnp.float32),
                lru_bx.astype(jnp.float32), lru_lambda.astype(jnp.float32)).astype(hn.dtype)
    y_lru = hl * jax.nn.gelu(gr)
    return jnp.concatenate([y_ssd, y_lru], axis=-1) @ w_out


def memory_cross_attention(hn, mn, w_q, w_kv, w_o):
    b, s, d = hn.shape
    m = mn.shape[1]
    q = (hn @ w_q).reshape(b, s, X_HEADS, X_HEAD_DIM)
    kv = mn @ w_kv
    k = kv[..., :d].reshape(b, m, X_HEADS, X_HEAD_DIM)
    v = kv[..., d:].reshape(b, m, X_HEADS, X_HEAD_DIM)
    scores = jnp.einsum('bshd,bmhd->bhsm', q, k).astype(jnp.float32) * (X_HEAD_DIM ** -0.5)
    probs = jax.nn.softmax(scores, axis=-1).astype(v.dtype)
    o = jnp.einsum('bhsm,bmhd->bshd', probs, v).reshape(b, s, d)
    return o @ w_o


def moe_ffn(hn, w_router, b_router, w_gate_up, b_gate_up, w_down, b_down):
    b, s, d = hn.shape
    t = b * s
    xt = hn.reshape(t, d)
    logits = (xt @ w_router + b_router).astype(jnp.float32)
    top_val, top_idx = lax.top_k(logits, TOP_K)
    gate = jax.nn.softmax(top_val, axis=-1)
    n_pairs = t * TOP_K
    flat_e = top_idx.reshape(-1).astype(jnp.int32)
    flat_tok = jnp.arange(n_pairs, dtype=jnp.int32) // TOP_K
    flat_gate = gate.reshape(-1)
    order = jnp.argsort(flat_e)
    se, stok, sg = flat_e[order], flat_tok[order], flat_gate[order]
    counts = jnp.bincount(flat_e, length=N_EXPERTS).astype(jnp.int32)
    pcounts = (counts + MOE_BLOCK - 1) // MOE_BLOCK * MOE_BLOCK
    start = jnp.cumsum(counts) - counts
    pend = jnp.cumsum(pcounts)
    pstart = pend - pcounts
    dest = pstart[se] + (jnp.arange(n_pairs, dtype=jnp.int32) - start[se])
    n_blocks = (n_pairs + N_EXPERTS * (MOE_BLOCK - 1) + MOE_BLOCK - 1) // MOE_BLOCK
    rows = n_blocks * MOE_BLOCK
    row_tok = jnp.full((rows,), t, dtype=jnp.int32).at[dest].set(stok)
    row_gate = jnp.zeros((rows,), jnp.float32).at[dest].set(sg)
    block_e = jnp.searchsorted(pend, jnp.arange(n_blocks, dtype=jnp.int32) * MOE_BLOCK, side='right')
    block_e = jnp.minimum(block_e, N_EXPERTS - 1).astype(jnp.int32)
    xpad = jnp.concatenate([xt, jnp.zeros((1, d), xt.dtype)], axis=0)
    xrows = xpad[row_tok].reshape(n_blocks, MOE_BLOCK, d)

    def expert_block(args):
        xb, e = args
        gu = xb @ w_gate_up[e] + b_gate_up[e]
        g_ = jnp.minimum(gu[..., ::2], SWIGLU_LIMIT)
        u_ = jnp.clip(gu[..., 1::2], -SWIGLU_LIMIT, SWIGLU_LIMIT)
        act = (u_ + 1.0) * (g_ * jax.nn.sigmoid(SWIGLU_ALPHA * g_))
        return act @ w_down[e] + b_down[e]

    yrows = lax.map(expert_block, (xrows, block_e)).reshape(rows, d)
    yrows = yrows * row_gate[:, None].astype(yrows.dtype)
    out = jax.ops.segment_sum(yrows, row_tok, num_segments=t + 1)[:t]
    return out.reshape(b, s, d)


def setup_inputs(seed: int = 0) -> dict:
    key = jax.random.key(seed)
    ks = iter(jax.random.split(key, 40))
    L = DEPTH

    def nrm(shape, scale):
        return jax.random.normal(next(ks), shape, jnp.float32) * scale

    def gain(shape):
        return 1.0 + nrm(shape, 0.02)

    def unif(shape, lo, hi):
        return jax.random.uniform(next(ks), shape, jnp.float32, lo, hi)

    x = nrm((BATCH, SEQ, D_MODEL), 1.0)
    mem = nrm((BATCH, N_MEM, D_MODEL), 1.0)
    norm_mix = gain((L, D_MODEL))
    w_in = nrm((L, D_MODEL, IN_PROJ), D_MODEL ** -0.5)
    ssd_conv_w = nrm((L, SSD_CONV, SSD_CONV_DIM), SSD_CONV ** -0.5)
    ssd_conv_b = nrm((L, SSD_CONV_DIM), 0.01)
    dt0 = jnp.exp(unif((L, SSD_HEADS), float(np.log(1e-3)), float(np.log(1e-1))))
    ssd_dt_bias = dt0 + jnp.log(-jnp.expm1(-dt0))
    ssd_a_log = jnp.log(unif((L, SSD_HEADS), 1.0, 16.0))
    ssd_d = gain((L, SSD_HEADS))
    ssd_norm = gain((L, SSD_WIDTH))
    lru_conv_w = nrm((L, LRU_CONV, LRU_WIDTH), LRU_CONV ** -0.5)
    lru_conv_b = nrm((L, LRU_WIDTH), 0.01)
    lru_wa = nrm((L, LRU_BLOCKS, LRU_BLOCK_W, LRU_BLOCK_W), LRU_BLOCK_W ** -0.5)
    lru_ba = nrm((L, LRU_WIDTH), 0.01)
    lru_wx = nrm((L, LRU_BLOCKS, LRU_BLOCK_W, LRU_BLOCK_W), LRU_BLOCK_W ** -0.5)
    lru_bx = nrm((L, LRU_WIDTH), 0.01)
    a0 = unif((L, LRU_WIDTH), 0.9, 0.999) ** (1.0 / RG_C)
    lru_lambda = jnp.log(a0) - jnp.log1p(-a0)
    w_out = nrm((L, MIX_WIDTH, D_MODEL), MIX_WIDTH ** -0.5)
    norm_xattn = gain((L, D_MODEL))
    norm_mem = gain((L, D_MODEL))
    w_q = nrm((L, D_MODEL, D_MODEL), D_MODEL ** -0.5)
    w_kv = nrm((L, D_MODEL, 2 * D_MODEL), D_MODEL ** -0.5)
    w_o = nrm((L, D_MODEL, D_MODEL), D_MODEL ** -0.5)
    norm_moe = gain((L, D_MODEL))
    w_router = nrm((L, D_MODEL, N_EXPERTS), D_MODEL ** -0.5)
    b_router = nrm((L, N_EXPERTS), 0.01)
    w_gate_up = nrm((L, N_EXPERTS, D_MODEL, 2 * D_FF), D_MODEL ** -0.5)
    b_gate_up = nrm((L, N_EXPERTS, 2 * D_FF), 0.01)
    w_down = nrm((L, N_EXPERTS, D_FF, D_MODEL), D_FF ** -0.5)
    b_down = nrm((L, N_EXPERTS, D_MODEL), 0.01)
    norm_final = gain((D_MODEL,))
    return {'x': x, 'mem': mem, 'norm_mix': norm_mix, 'w_in': w_in,
            'ssd_conv_w': ssd_conv_w, 'ssd_conv_b': ssd_conv_b, 'ssd_dt_bias': ssd_dt_bias,
            'ssd_a_log': ssd_a_log, 'ssd_d': ssd_d, 'ssd_norm': ssd_norm,
            'lru_conv_w': lru_conv_w, 'lru_conv_b': lru_conv_b, 'lru_wa': lru_wa, 'lru_ba': lru_ba,
            'lru_wx': lru_wx, 'lru_bx': lru_bx, 'lru_lambda': lru_lambda, 'w_out': w_out,
            'norm_xattn': norm_xattn, 'norm_mem': norm_mem, 'w_q': w_q, 'w_kv': w_kv, 'w_o': w_o,
            'norm_moe': norm_moe, 'w_router': w_router, 'b_router': b_router,
            'w_gate_up': w_gate_up, 'b_gate_up': b_gate_up, 'w_down': w_down, 'b_down': b_down,
            'norm_final': norm_final}


def reference(x, mem, norm_mix, w_in, ssd_conv_w, ssd_conv_b, ssd_dt_bias, ssd_a_log, ssd_d, ssd_norm,
              lru_conv_w, lru_conv_b, lru_wa, lru_ba, lru_wx, lru_bx, lru_lambda, w_out,
              norm_xattn, norm_mem, w_q, w_kv, w_o, norm_moe, w_router, b_router,
              w_gate_up, b_gate_up, w_down, b_down, norm_final):
    h = x
    for l in range(DEPTH):
        h = h + hybrid_mixer(rmsnorm(h, norm_mix[l]), w_in[l], ssd_conv_w[l], ssd_conv_b[l], ssd_dt_bias[l],
                             ssd_a_log[l], ssd_d[l], ssd_norm[l], lru_conv_w[l], lru_conv_b[l], lru_wa[l],
                             lru_ba[l], lru_wx[l], lru_bx[l], lru_lambda[l], w_out[l])
        h = h + memory_cross_attention(rmsnorm(h, norm_xattn[l]), rmsnorm(mem, norm_mem[l]),
                                       w_q[l], w_kv[l], w_o[l])
        h = h + moe_ffn(rmsnorm(h, norm_moe[l]), w_router[l], b_router[l], w_gate_up[l], b_gate_up[l],
                        w_down[l], b_down[l])
    return rmsnorm(h, norm_final)
```

```cpp
#include <hip/hip_runtime.h>
#include <cstdio>
#include <cstdint>

#ifndef MK_N_LAUNCHES
#define MK_N_LAUNCHES 1
#endif
#ifndef DBG_SSD
#define DBG_SSD 0
#endif
#ifndef REPEAT_MASK
#define REPEAT_MASK 0
#endif
#define NREP(k) (((REPEAT_MASK >> (k)) & 1) ? 2 : 1)
#ifndef REP_SSD
#define REP_SSD 0
#endif
#ifndef REP_LRU
#define REP_LRU 0
#endif
#ifndef REP0
#define REP0 0
#endif
#ifndef EXTRA_BARS
#define EXTRA_BARS 0
#endif
#ifndef DBG_STOP
#define DBG_STOP 13
#endif
#ifndef DBG_DUMP
#define DBG_DUMP 0
#endif
#define LAS __attribute__((address_space(3)))
#define GAS __attribute__((address_space(1)))

typedef unsigned short bf16_t;
typedef short bf16x8 __attribute__((ext_vector_type(8)));
typedef float f32x4 __attribute__((ext_vector_type(4)));
typedef float f32x2 __attribute__((ext_vector_type(2)));
typedef unsigned u32x4 __attribute__((ext_vector_type(4)));
typedef unsigned u32x2 __attribute__((ext_vector_type(2)));

constexpr int T = 32768, D = 1024, NBATCH = 8, SEQ = 4096, NMEM = 256, MT = NBATCH * NMEM;
constexpr int NPROJ = 5120;
constexpr int PC_X = 1024, PC_XR = 3072, PC_GR = 4096;
constexpr int NCV = 3072;
constexpr int NE = 32, NPAIR = T * 4;
constexpr float EPS = 1e-6f;
constexpr int NPHASE = 14;

constexpr size_t MiB = 1u << 20;
constexpr size_t WS_CTL = 0, CTL_ZERO_BYTES = 256 * 1024;
constexpr size_t WS_WIN = 1 * MiB, WS_WOUT = 11 * MiB, WS_WQ = 15 * MiB, WS_WK = 17 * MiB, WS_WV = 19 * MiB, WS_WO = 21 * MiB;
constexpr size_t WS_WR = 23 * MiB, WS_CB = 23 * MiB + 256 * 1024;
constexpr size_t WS_CBIN = 23 * MiB + 512 * 1024, WS_RSC = 23 * MiB + 576 * 1024;
constexpr size_t WS_CBQ = 23 * MiB + 704 * 1024;
constexpr float H1Q_CLIP = 16.0f;
constexpr size_t WS_CBD = 23 * MiB + 768 * 1024;
constexpr float ACTQ_CLIP = 12.0f;
constexpr size_t WS_MSC = 23 * MiB + 900 * 1024, WS_CBKV = 23 * MiB + 912 * 1024;
constexpr size_t WS_WGU = 24 * MiB, WS_WD = 152 * MiB;
constexpr size_t WS_MNB = 216 * MiB, WS_DTV = 220 * MiB, WS_ACS = 222 * MiB, WS_SSQ = 224 * MiB, WS_SS1 = 226 * MiB, WS_SS2 = 228 * MiB;
constexpr size_t WS_KM = 230 * MiB, WS_VT = 234 * MiB, WS_LTOK = 238 * MiB, WS_LGATE = 242 * MiB, WS_LRSTD = 246 * MiB, WS_PAIR = 250 * MiB;
constexpr size_t WS_RC = 252 * MiB;
constexpr size_t WS_RA = 316 * MiB;
constexpr size_t WS_RB = 636 * MiB;
constexpr size_t WS_END = 956 * MiB;
constexpr size_t WS_HN = WS_RC, WS_Q = WS_RC, WS_PROJ = WS_RA, WS_ACT = WS_RA, WS_CV = WS_RB, WS_YCAT = WS_RB + 192 * MiB, WS_HB = WS_RB, WS_P = WS_RB + 64 * MiB, WS_HQ = WS_RB + 64 * MiB  , WS_YB = WS_RB, WS_H = WS_RA + 192 * MiB  ;
constexpr int CW_BAR = 4096;
constexpr int CW_CNT = 32768;
constexpr int CW_TICKET = 40960;
#ifndef ROUTER_TICKET
#define ROUTER_TICKET 0
#endif

constexpr int RING_BYTES = 131072;
constexpr int XCH_OFF = RING_BYTES;
constexpr int TAB_OFF = RING_BYTES + 8192;
constexpr int MISC_OFF = RING_BYTES + 8192 + 512;
constexpr int LDS_BYTES = 147456;

__device__ __forceinline__ unsigned f2bf(float f) { unsigned u = __builtin_bit_cast(unsigned, f); return (u + 0x7fffu + ((u >> 16) & 1u)) >> 16; }
__device__ __forceinline__ float bf2f(unsigned h) { return __builtin_bit_cast(float, h << 16); }
typedef __bf16 bf16x2_t __attribute__((ext_vector_type(2)));
__device__ __forceinline__ unsigned cvt_pk_bf16(float lo, float hi) { const f32x2 v = (f32x2){lo, hi}; const bf16x2_t b = __builtin_convertvector(v, bf16x2_t); return __builtin_bit_cast(unsigned, b); }
__device__ __forceinline__ float bflo(unsigned w) { return __builtin_bit_cast(float, w << 16); }
__device__ __forceinline__ float bfhi(unsigned w) { return __builtin_bit_cast(float, w & 0xffff0000u); }
__device__ __forceinline__ float sigmoidf_(float x) { return __builtin_amdgcn_rcpf(1.0f + __expf(-x)); }
__device__ __forceinline__ float siluf_(float x) { return x * sigmoidf_(x); }
__device__ __forceinline__ float softplusf_(float x) { return x > 20.f ? x : log1pf(__expf(x)); }
__device__ __forceinline__ float gelu_tanhf_(float x) { const float y = 1.5957691216057308f * (x + 0.044715f * x * x * x); return x * __builtin_amdgcn_rcpf(1.0f + __expf(-y)); }
__device__ __forceinline__ float neg_expm1f_(float x) { const float p = x * (1.0f + x * (0.5f + x * (0.16666667f + x * (0.041666668f + x * 0.0083333338f)))); return x > -0.5f ? -p : 1.0f - __expf(x); }
__device__ __forceinline__ float wave_sum(float v) {
#pragma unroll
    for (int o = 1; o < 64; o <<= 1) v += __shfl_xor(v, o);
    return v;
}
__device__ __forceinline__ int lane_id_() { int l = (int)__builtin_amdgcn_mbcnt_hi(~0u, __builtin_amdgcn_mbcnt_lo(~0u, 0u)); asm volatile("" : "+v"(l)); return l; }
#define LDS_WAIT() asm volatile("s_waitcnt lgkmcnt(0)" ::: "memory")
#define VM_WAIT() asm volatile("s_waitcnt vmcnt(0)" ::: "memory")

namespace pg8 {
constexpr int BM = 256, BK = 64, HALF = 128, HTB = HALF * BK * 2, STAGE_BYTES = 8 * HTB;
__host__ __device__ __forceinline__ int lds_byte(int r, int c) { const int st = (r >> 4) * 2 + (c >> 5), rr = r & 15, cc = c & 31, ob = rr * 64 + cc * 2; return st * 1024 + (ob ^ (((ob >> 9) & 1) << 5)); }
__host__ __device__ __forceinline__ void stage_rc(int b, int& R, int& C) { const int st = b / 1024, sb = b % 1024, swz = sb ^ (((sb >> 9) & 1) << 5); R = (st >> 1) * 16 + swz / 64; C = (st & 1) * 32 + (swz % 64) / 2; }
__host__ __device__ __forceinline__ int perm32(int rho) { const int n = rho >> 4, i = rho & 15; return 8 * (i >> 2) + 4 * n + (i & 3); }

struct Unit { int row0, col0, aux, nvalid, lbase; const char* A; const char* B; };

typedef f32x4 Acc[2][2][4][2];
typedef int i32x4 __attribute__((ext_vector_type(4)));
typedef i32x4 AccI[2][2][4][2];
template <bool I8> struct AccSel { typedef f32x4 T; };
template <> struct AccSel<true> { typedef i32x4 T; };

struct NoKHook { static constexpr bool ON = false; __device__ __forceinline__ void prepare(const Unit&, LAS unsigned char*, int) const {} template <class A> __device__ __forceinline__ void at(int, A&, int, int, LAS unsigned char*) const {} };
template <class Epi, class Sched, bool GATHER, bool I8 = false, class KHook = NoKHook>
__device__ __forceinline__ void gemm_phase(const int wid_in, LAS unsigned char* lds, const int lda_b, const int ldb_b, const int K, const Sched& S, const Epi& E, const KHook& KH = KHook()) {
    const int wid = __builtin_amdgcn_readfirstlane(wid_in), lane = lane_id_(), tid = wid * 64 + lane, wr = wid >> 2, wc = wid & 3, fr = lane & 15, fq = lane >> 4;
    const int nt = K / BK;
    int RA[2], CA[2]; unsigned voffB[2];
#pragma unroll
    for (int i = 0; i < 2; ++i) { int R, C; stage_rc(tid * 16 + i * 8192, R, C); const int Rb = (R & ~31) + perm32(R & 31); RA[i] = R; CA[i] = C * 2; voffB[i] = (unsigned)(Rb * ldb_b + C * 2); }
    const size_t kstep = (size_t)(BK * 2);
    const size_t hstepB = (size_t)HALF * ldb_b;
    const unsigned ldsw = (unsigned)wid * 1024u;
    const int aoff = lds_byte(wr * 64 + fr, fq * 8), boff = lds_byte(wc * 32 + fr, fq * 8);
#define PG8_SA(b, h) (((b) * 2 + (h)) * HTB)
#define PG8_SB(b, h) ((4 + (b) * 2 + (h)) * HTB)
#define PG8_STAGE(bufoff, gbase, voff) do { _Pragma("unroll") for (int _i = 0; _i < 2; ++_i) \
        __builtin_amdgcn_global_load_lds((const unsigned*)((const char*)(gbase) + (voff)[_i]), (LAS unsigned*)(lds + (bufoff) + ldsw + _i * 8192), 16, 0, 0); } while (0)
#define PG8_LDA(dst, b, h) do { _Pragma("unroll") for (int m = 0; m < 4; ++m) _Pragma("unroll") for (int k = 0; k < 2; ++k) dst[m][k] = *(const LAS bf16x8*)(lds + PG8_SA(b, h) + aoff + m * 2048 + k * 1024); } while (0)
#define PG8_LDB(dst, b, h) do { _Pragma("unroll") for (int n = 0; n < 2; ++n) _Pragma("unroll") for (int k = 0; k < 2; ++k) dst[n][k] = *(const LAS bf16x8*)(lds + PG8_SB(b, h) + boff + n * 2048 + k * 1024); } while (0)
#define PG8_MMA(ai, bj, At, Bt) do { __builtin_amdgcn_s_setprio(1); _Pragma("unroll") for (int m = 0; m < 4; ++m) _Pragma("unroll") for (int n = 0; n < 2; ++n) _Pragma("unroll") for (int k = 0; k < 2; ++k) { \
        if constexpr (I8) acc[ai][bj][m][n] = __builtin_bit_cast(acc_t, __builtin_amdgcn_mfma_i32_16x16x64_i8(__builtin_bit_cast(i32x4, Bt[n][k]), __builtin_bit_cast(i32x4, At[m][k]), __builtin_bit_cast(i32x4, acc[ai][bj][m][n]), 0, 0, 0)); \
        else acc[ai][bj][m][n] = __builtin_bit_cast(acc_t, __builtin_amdgcn_mfma_f32_16x16x32_bf16(Bt[n][k], At[m][k], __builtin_bit_cast(f32x4, acc[ai][bj][m][n]), 0, 0, 0)); } __builtin_amdgcn_s_setprio(0); } while (0)
#define PG8_WAIT_V(n) asm volatile("s_waitcnt vmcnt(" #n ")" ::: "memory")
#define PG8_WAIT_L(n) asm volatile("s_waitcnt lgkmcnt(" #n ")" ::: "memory")
#define PG8_BAR __builtin_amdgcn_s_barrier()
#define PG8_SCHED __builtin_amdgcn_sched_barrier(0)
#define PG8_ZERO() do { _Pragma("unroll") for (int a = 0; a < 2; ++a) _Pragma("unroll") for (int b = 0; b < 2; ++b) _Pragma("unroll") for (int m = 0; m < 4; ++m) _Pragma("unroll") for (int n = 0; n < 2; ++n) acc[a][b][m][n] = (acc_t){0, 0, 0, 0}; } while (0)
    Unit cur, nxt; int ui = 0;
    if (!S.next(0, cur)) return;
    typedef typename AccSel<I8>::T acc_t; acc_t acc[2][2][4][2]; PG8_ZERO();
    bf16x8 At[4][2], B0[2][2], B1[2][2];
    unsigned cvA[2][2], nvA[2][2];
    int nnT[2][2];
    S.a_offs(cur, RA, CA, lda_b, cvA);
    bool has_next = S.next(1, nxt); Unit nx2;
    if (GATHER) { if (has_next) S.a_offs(nxt, RA, CA, lda_b, nvA); else { nvA[0][0] = cvA[0][0]; nvA[0][1] = cvA[0][1]; nvA[1][0] = cvA[1][0]; nvA[1][1] = cvA[1][1]; } }
    const char* cA = cur.A; const char* cB = cur.B;
    if constexpr (KHook::ON) KH.prepare(cur, lds, tid);
    PG8_STAGE(PG8_SB(0, 0), cB, voffB); PG8_STAGE(PG8_SB(0, 1), cB + hstepB, voffB); PG8_STAGE(PG8_SA(0, 0), cA, cvA[0]); PG8_STAGE(PG8_SA(0, 1), cA, cvA[1]);
    if (wr == 1) PG8_BAR;
    PG8_WAIT_V(2); PG8_BAR;
    PG8_STAGE(PG8_SB(1, 0), cB + kstep, voffB); PG8_STAGE(PG8_SA(1, 0), cA + kstep, cvA[0]); PG8_STAGE(PG8_SB(1, 1), cB + hstepB + kstep, voffB);
    PG8_WAIT_V(6); PG8_BAR;
    for (;;) {
        const char* nA = has_next ? nxt.A : cA; const char* nB = has_next ? nxt.B : cB;
        const bool has_nx2 = has_next && S.next(ui + 2, nx2);
        if (GATHER) { if (has_nx2) S.a_rows(nx2, RA, nnT); }
#pragma unroll 1
        for (int t = 0; t < nt; t += 2) {
            const bool last = (t == nt - 2);
            if constexpr (KHook::ON) KH.at(t, acc, wr, fr, lds);
            const char* a1 = cA + (size_t)(t + 1) * kstep;
            const char* a2 = last ? nA : cA + (size_t)(t + 2) * kstep; const char* b2 = last ? nB : cB + (size_t)(t + 2) * kstep;
            const char* a3 = a2 + kstep; const char* b3 = b2 + kstep;
            unsigned vA2[2][2];
            if (GATHER) { vA2[0][0] = last ? nvA[0][0] : cvA[0][0]; vA2[0][1] = last ? nvA[0][1] : cvA[0][1]; vA2[1][0] = last ? nvA[1][0] : cvA[1][0]; vA2[1][1] = last ? nvA[1][1] : cvA[1][1]; }
            else { vA2[0][0] = cvA[0][0]; vA2[0][1] = cvA[0][1]; vA2[1][0] = cvA[1][0]; vA2[1][1] = cvA[1][1]; }
            PG8_LDB(B0, 0, 0); PG8_LDB(B1, 0, 1); PG8_SCHED; PG8_LDA(At, 0, 0); PG8_STAGE(PG8_SA(1, 1), a1, cvA[1]);
            PG8_WAIT_V(8); PG8_WAIT_L(0); PG8_BAR; PG8_MMA(0, 0, At, B0); PG8_MMA(0, 1, At, B1); PG8_BAR; PG8_SCHED;
            PG8_LDA(At, 0, 1); PG8_STAGE(PG8_SB(0, 0), b2, voffB); PG8_STAGE(PG8_SB(0, 1), b2 + hstepB, voffB); PG8_STAGE(PG8_SA(0, 0), a2, vA2[0]);
            PG8_WAIT_V(8); PG8_WAIT_L(0); PG8_BAR; PG8_MMA(1, 0, At, B0); PG8_MMA(1, 1, At, B1); PG8_BAR; PG8_SCHED;
            PG8_LDB(B0, 1, 0); PG8_LDB(B1, 1, 1); PG8_SCHED; PG8_LDA(At, 1, 0); PG8_STAGE(PG8_SA(0, 1), a2, vA2[1]);
            PG8_WAIT_V(8); PG8_WAIT_L(0); PG8_BAR; PG8_MMA(0, 0, At, B0); PG8_MMA(0, 1, At, B1); PG8_BAR; PG8_SCHED;
            PG8_LDA(At, 1, 1); PG8_STAGE(PG8_SB(1, 0), b3, voffB); PG8_STAGE(PG8_SB(1, 1), b3 + hstepB, voffB); PG8_STAGE(PG8_SA(1, 0), a3, vA2[0]);
            PG8_WAIT_V(8); PG8_WAIT_L(0); PG8_BAR; PG8_MMA(1, 0, At, B0); PG8_MMA(1, 1, At, B1); PG8_BAR; PG8_SCHED;
        }
        if (wr == 0) PG8_BAR;
        if constexpr (GATHER) { auto hook = [&]() { if (has_nx2) {
#pragma unroll
                    for (int h = 0; h < 2; ++h)
#pragma unroll
                        for (int i = 0; i < 2; ++i) asm volatile("" : "+v"(nnT[h][i])); } };
            E(acc, cur, wr, wc, fr, fq, lds, hook); }
        else E(acc, cur, wr, wc, fr, fq, lds);
        if (!has_next) break;
        if constexpr (KHook::ON) KH.prepare(nxt, lds, tid);
        PG8_ZERO();
        cur = nxt; cA = nA; cB = nB; ++ui;
        if (GATHER) { cvA[0][0] = nvA[0][0]; cvA[0][1] = nvA[0][1]; cvA[1][0] = nvA[1][0]; cvA[1][1] = nvA[1][1];
            if (has_nx2) {
#pragma unroll
                for (int h = 0; h < 2; ++h)
#pragma unroll
                    for (int i = 0; i < 2; ++i) nvA[h][i] = (unsigned)nnT[h][i] * (unsigned)lda_b + (unsigned)CA[i]; } }
        if (has_next) { nxt = nx2; } has_next = has_nx2;
        if (wr == 1) PG8_BAR;
    }
    PG8_WAIT_V(0);
    PG8_BAR;
#undef PG8_SA
#undef PG8_SB
#undef PG8_STAGE
#undef PG8_LDA
#undef PG8_LDB
#undef PG8_MMA
#undef PG8_WAIT_V
#undef PG8_WAIT_L
#undef PG8_BAR
#undef PG8_SCHED
#undef PG8_ZERO
}

struct DenseSched {
    int nM, nN, nwg, G, c, lda_b, ldb_b; const char* A; const char* B;
    __device__ __forceinline__ void init(int M, int N, int G_, int c_, const void* A_, const void* B_, int lda_b_, int ldb_b_) { nM = M / BM; nN = N / BM; nwg = nM * nN; G = G_; c = c_; A = (const char*)A_; B = (const char*)B_; lda_b = lda_b_; ldb_b = ldb_b_; }
    __device__ __forceinline__ bool next(int i, Unit& u) const {
        const long L = (long)i * G + c; if (L >= nwg) return false;
        int wgid = (int)L; { const int q = nwg / 8, r = nwg % 8, xcd = wgid % 8, off = wgid / 8; wgid = (xcd < r ? xcd * (q + 1) : r * (q + 1) + (xcd - r) * q) + off; }
        const int nig = 8 * nN, gid = wgid / nig, fm = gid * 8, gsz = (nM - fm) < 8 ? (nM - fm) : 8;
        const int pm = fm + ((wgid % nig) % gsz), pn = (wgid % nig) / gsz;
        u.row0 = pm * BM; u.col0 = pn * BM; u.aux = 0; u.nvalid = BM; u.lbase = 0;
        u.A = A + (size_t)pm * BM * lda_b; u.B = B + (size_t)pn * BM * ldb_b; return true;
    }
    __device__ __forceinline__ void a_rows(const Unit&, const int (&)[2], int (&)[2][2]) const {}
    __device__ __forceinline__ void a_offs(const Unit&, const int (&RA)[2], const int (&CA)[2], int lda_b_, unsigned (&v)[2][2]) const {
#pragma unroll
        for (int h = 0; h < 2; ++h)
#pragma unroll
            for (int i = 0; i < 2; ++i) v[h][i] = (unsigned)((RA[i] + HALF * h) * lda_b_ + CA[i]);
    }
};
}
using pg8::Unit; using pg8::Acc; using pg8::AccI; using pg8::i32x4;

__device__ __forceinline__ unsigned pack_i8x4(float a, float b, float c, float d) {
    unsigned w = 0;
    w = __builtin_amdgcn_cvt_pk_u8_f32(rintf(a) + 128.0f, 0, w); w = __builtin_amdgcn_cvt_pk_u8_f32(rintf(b) + 128.0f, 1, w);
    w = __builtin_amdgcn_cvt_pk_u8_f32(rintf(c) + 128.0f, 2, w); w = __builtin_amdgcn_cvt_pk_u8_f32(rintf(d) + 128.0f, 3, w);
    return w ^ 0x80808080u;
}
#define EPI_ROW(ai, m) (128 * (ai) + 64 * wr + 16 * (m) + fr)
#define EPI_COL(bj) (128 * (bj) + 32 * wc + 8 * fq)
__device__ __forceinline__ u32x4 pack8(const f32x4 v0, const f32x4 v1) { u32x4 w; w.x = cvt_pk_bf16(v0[0], v0[1]); w.y = cvt_pk_bf16(v0[2], v0[3]); w.z = cvt_pk_bf16(v1[0], v1[1]); w.w = cvt_pk_bf16(v1[2], v1[3]); return w; }

struct EpiBf16 {
    bf16_t* O0; int ldc0; bf16_t* O1; int ldc1;
    __device__ __forceinline__ void operator()(const Acc& acc, const Unit& u, int wr, int wc, int fr, int fq, LAS unsigned char*) const {
        asm volatile("" : "+v"(fr), "+v"(fq));
        bf16_t* O = u.aux ? O1 : O0; const int ldc = u.aux ? ldc1 : ldc0;
#pragma unroll
        for (int ai = 0; ai < 2; ++ai)
#pragma unroll
            for (int m = 0; m < 4; ++m) { bf16_t* rowp = O + (size_t)(u.row0 + EPI_ROW(ai, m)) * ldc + u.col0;
#pragma unroll
                for (int bj = 0; bj < 2; ++bj) *(u32x4*)(rowp + EPI_COL(bj)) = pack8(acc[ai][bj][m][0], acc[ai][bj][m][1]); }
    }
};
struct EpiKVI8 {
    bf16_t* KM; bf16_t* VT; const float* msc; const float* cbkv;
    __device__ __forceinline__ void operator()(const AccI& acc, const Unit& u, int wr, int wc, int fr, int fq, LAS unsigned char*) const {
        asm volatile("" : "+v"(fr), "+v"(fq));
        bf16_t* O = u.aux ? VT : KM; const int ldc = u.aux ? 2048 : 1024; const float* rsc = u.aux ? cbkv + 1024 : msc; const float* csc = u.aux ? msc : cbkv;
        f32x4 cs[2][2];
#pragma unroll
        for (int bj = 0; bj < 2; ++bj)
#pragma unroll
            for (int n = 0; n < 2; ++n) cs[bj][n] = *(const f32x4*)(csc + u.col0 + EPI_COL(bj) + 4 * n);
        float rv[2][4];
#pragma unroll
        for (int ai = 0; ai < 2; ++ai)
#pragma unroll
            for (int m = 0; m < 4; ++m) rv[ai][m] = rsc[u.row0 + EPI_ROW(ai, m)];
#pragma unroll
        for (int ai = 0; ai < 2; ++ai)
#pragma unroll
            for (int m = 0; m < 4; ++m) { bf16_t* rowp = O + (size_t)(u.row0 + EPI_ROW(ai, m)) * ldc + u.col0; const float rs = rv[ai][m];
#pragma unroll
                for (int bj = 0; bj < 2; ++bj) { f32x4 v0, v1;
#pragma unroll
                    for (int i = 0; i < 4; ++i) { v0[i] = (float)acc[ai][bj][m][0][i] * (rs * cs[bj][0][i]); v1[i] = (float)acc[ai][bj][m][1][i] * (rs * cs[bj][1][i]); }
                    *(u32x4*)(rowp + EPI_COL(bj)) = pack8(v0, v1); } }
    }
};
struct EpiI8Scale {
    bf16_t* O; int ldc; const float* rsc; const float* csc;
    __device__ __forceinline__ void operator()(const AccI& acc, const Unit& u, int wr, int wc, int fr, int fq, LAS unsigned char*) const {
        asm volatile("" : "+v"(fr), "+v"(fq));
        f32x4 cs[2][2];
#pragma unroll
        for (int bj = 0; bj < 2; ++bj)
#pragma unroll
            for (int n = 0; n < 2; ++n) cs[bj][n] = *(const f32x4*)(csc + u.col0 + EPI_COL(bj) + 4 * n);
        float rv[2][4];
#pragma unroll
        for (int ai = 0; ai < 2; ++ai)
#pragma unroll
            for (int m = 0; m < 4; ++m) rv[ai][m] = rsc[u.row0 + EPI_ROW(ai, m)];
#pragma unroll
        for (int ai = 0; ai < 2; ++ai)
#pragma unroll
            for (int m = 0; m < 4; ++m) { bf16_t* rowp = O + (size_t)(u.row0 + EPI_ROW(ai, m)) * ldc + u.col0; const float rs = rv[ai][m];
#pragma unroll
                for (int bj = 0; bj < 2; ++bj) { u32x4 w;
#pragma unroll
                    for (int n = 0; n < 2; ++n)
#pragma unroll
                        for (int ip = 0; ip < 2; ++ip) {
                            const f32x2 a2 = (f32x2){(float)acc[ai][bj][m][n][2 * ip], (float)acc[ai][bj][m][n][2 * ip + 1]};
                            const f32x2 v2 = a2 * ((f32x2){cs[bj][n][2 * ip], cs[bj][n][2 * ip + 1]} * rs);
                            w[2 * n + ip] = cvt_pk_bf16(v2[0], v2[1]); }
                    *(u32x4*)(rowp + EPI_COL(bj)) = w; } }
    }
};
struct EpiRowScaleI8 {
    bf16_t* O; int ldc; const float* ss; const float* csc; float asc;
    __device__ __forceinline__ void operator()(const AccI& acc, const Unit& u, int wr, int wc, int fr, int fq, LAS unsigned char*) const {
        asm volatile("" : "+v"(fr), "+v"(fq));
        f32x4 cs[2][2];
#pragma unroll
        for (int bj = 0; bj < 2; ++bj)
#pragma unroll
            for (int n = 0; n < 2; ++n) cs[bj][n] = *(const f32x4*)(csc + u.col0 + EPI_COL(bj) + 4 * n) * asc;
#pragma unroll
        for (int ai = 0; ai < 2; ++ai) {
            f32x4 sp[4][4];
#pragma unroll
            for (int m = 0; m < 4; ++m) { const f32x4* p = (const f32x4*)(ss + (size_t)(u.row0 + EPI_ROW(ai, m)) * 16);
#pragma unroll
                for (int q = 0; q < 4; ++q) sp[m][q] = p[q]; }
#pragma unroll
            for (int m = 0; m < 4; ++m) { const int row = u.row0 + EPI_ROW(ai, m);
                const f32x4 s0 = sp[m][0], s1 = sp[m][1], s2 = sp[m][2], s3 = sp[m][3];
                const float tot = ((s0[0] + s0[1]) + (s0[2] + s0[3])) + ((s1[0] + s1[1]) + (s1[2] + s1[3])) + ((s2[0] + s2[1]) + (s2[2] + s2[3])) + ((s3[0] + s3[1]) + (s3[2] + s3[3]));
                const float rs = rsqrtf(tot * (1.0f / D) + EPS);
                bf16_t* rowp = O + (size_t)row * ldc + u.col0;
#pragma unroll
                for (int bj = 0; bj < 2; ++bj) { f32x4 v0, v1;
#pragma unroll
                    for (int i = 0; i < 4; ++i) { v0[i] = (float)acc[ai][bj][m][0][i] * (rs * cs[bj][0][i]); v1[i] = (float)acc[ai][bj][m][1][i] * (rs * cs[bj][1][i]); }
                    *(u32x4*)(rowp + EPI_COL(bj)) = pack8(v0, v1); } }
        }
    }
};
struct EpiRowScale {
    bf16_t* O; int ldc; const float* ss;
    __device__ __forceinline__ void operator()(const Acc& acc, const Unit& u, int wr, int wc, int fr, int fq, LAS unsigned char*) const {
        asm volatile("" : "+v"(fr), "+v"(fq));
#pragma unroll
        for (int ai = 0; ai < 2; ++ai) {
            f32x4 sp[4][4];
#pragma unroll
            for (int m = 0; m < 4; ++m) { const f32x4* p = (const f32x4*)(ss + (size_t)(u.row0 + EPI_ROW(ai, m)) * 16);
#pragma unroll
                for (int q = 0; q < 4; ++q) sp[m][q] = p[q]; }
#pragma unroll
            for (int m = 0; m < 4; ++m) { const int row = u.row0 + EPI_ROW(ai, m);
                const f32x4 s0 = sp[m][0], s1 = sp[m][1], s2 = sp[m][2], s3 = sp[m][3];
                const float tot = ((s0[0] + s0[1]) + (s0[2] + s0[3])) + ((s1[0] + s1[1]) + (s1[2] + s1[3])) + ((s2[0] + s2[1]) + (s2[2] + s2[3])) + ((s3[0] + s3[1]) + (s3[2] + s3[3]));
                const float rs = rsqrtf(tot * (1.0f / D) + EPS);
                bf16_t* rowp = O + (size_t)row * ldc + u.col0;
#pragma unroll
                for (int bj = 0; bj < 2; ++bj) *(u32x4*)(rowp + EPI_COL(bj)) = pack8(acc[ai][bj][m][0] * rs, acc[ai][bj][m][1] * rs); }
        }
    }
};
template <int WB, bool BASE_BF16> struct EpiResid {
    const void* base; bf16_t* hb; bf16_t* ob; float* ss;
    __device__ __forceinline__ void operator()(const Acc& acc, const Unit& u, int wr, int wc, int fr, int fq, LAS unsigned char*) const {
        asm volatile("" : "+v"(fr), "+v"(fq));
#pragma unroll
        for (int ai = 0; ai < 2; ++ai)
#pragma unroll
            for (int m = 0; m < 4; ++m) { const int row = u.row0 + EPI_ROW(ai, m); const size_t off = (size_t)row * D + u.col0; float q = 0.f;
#pragma unroll
                for (int bj = 0; bj < 2; ++bj) { const int c = EPI_COL(bj);
                    f32x4 b0, b1;
                    if (BASE_BF16) { const u32x4 r = *(const u32x4*)((const bf16_t*)base + off + c); b0 = (f32x4){bflo(r.x), bfhi(r.x), bflo(r.y), bfhi(r.y)}; b1 = (f32x4){bflo(r.z), bfhi(r.z), bflo(r.w), bfhi(r.w)}; }
                    else { b0 = *(const f32x4*)((const float*)base + off + c); b1 = *(const f32x4*)((const float*)base + off + c + 4); }
                    const f32x4 v0 = b0 + acc[ai][bj][m][0], v1 = b1 + acc[ai][bj][m][1];
                    *(u32x4*)(hb + off + c) = pack8(v0, v1);
                    if (WB == 2) { u32x2 o; constexpr float QS = 127.0f / H1Q_CLIP;
                        o.x = pack_i8x4(v0[0] * QS, v0[1] * QS, v0[2] * QS, v0[3] * QS); o.y = pack_i8x4(v1[0] * QS, v1[1] * QS, v1[2] * QS, v1[3] * QS);
                        *(u32x2*)((unsigned char*)ob + off + c) = o; }
                    q += (v0[0] * v0[0] + v0[1] * v0[1]) + (v0[2] * v0[2] + v0[3] * v0[3]) + (v1[0] * v1[0] + v1[1] * v1[1]) + (v1[2] * v1[2] + v1[3] * v1[3]); }
                q += __shfl_xor(q, 16); q += __shfl_xor(q, 32);
                if (fq == 0) ss[(size_t)row * 16 + (u.col0 >> 8) * 4 + wc] = q; }
    }
};
struct EpiSoftmax {
    bf16_t* P;
    __device__ __forceinline__ void operator()(Acc& acc, const Unit& u, int wr, int wc, int fr, int fq, LAS unsigned char* lds) const {
        asm volatile("" : "+v"(fr), "+v"(fq));
        LAS f32x2* X = (LAS f32x2*)(lds + XCH_OFF);
        float mloc[2][4];
#pragma unroll
        for (int ai = 0; ai < 2; ++ai)
#pragma unroll
            for (int m = 0; m < 4; ++m) { float mx = -3.0e38f;
#pragma unroll
                for (int bj = 0; bj < 2; ++bj)
#pragma unroll
                    for (int n = 0; n < 2; ++n) { const f32x4 x = acc[ai][bj][m][n]; mx = fmaxf(mx, fmaxf(fmaxf(x[0], x[1]), fmaxf(x[2], x[3]))); }
                mx = fmaxf(mx, __shfl_xor(mx, 16)); mx = fmaxf(mx, __shfl_xor(mx, 32)); float s = 0.f;
#pragma unroll
                for (int bj = 0; bj < 2; ++bj)
#pragma unroll
                    for (int n = 0; n < 2; ++n) { f32x4 x = acc[ai][bj][m][n]; x[0] = __expf(x[0] - mx); x[1] = __expf(x[1] - mx); x[2] = __expf(x[2] - mx); x[3] = __expf(x[3] - mx); acc[ai][bj][m][n] = x; s += (x[0] + x[1]) + (x[2] + x[3]); }
                s += __shfl_xor(s, 16); s += __shfl_xor(s, 32);
                mloc[ai][m] = mx;
                if (fq == 0) X[EPI_ROW(ai, m) * 4 + wc] = (f32x2){mx, s}; }
        LDS_WAIT(); __builtin_amdgcn_s_barrier(); asm volatile("" ::: "memory");
#pragma unroll
        for (int ai = 0; ai < 2; ++ai)
#pragma unroll
            for (int m = 0; m < 4; ++m) { const int lr = EPI_ROW(ai, m);
                const f32x2 a = X[lr * 4 + 0], b = X[lr * 4 + 1], c = X[lr * 4 + 2], d = X[lr * 4 + 3];
                const float M = fmaxf(fmaxf(a.x, b.x), fmaxf(c.x, d.x));
                const float tot = a.y * __expf(a.x - M) + b.y * __expf(b.x - M) + c.y * __expf(c.x - M) + d.y * __expf(d.x - M);
                const float f = __expf(mloc[ai][m] - M) / tot;
                bf16_t* rowp = P + (size_t)(u.row0 + lr) * D + u.col0;
#pragma unroll
                for (int bj = 0; bj < 2; ++bj) *(u32x4*)(rowp + EPI_COL(bj)) = pack8(acc[ai][bj][m][0] * f, acc[ai][bj][m][1] * f); }
    }
};
struct EpiSwiglu {
    bf16_t* act; const float* bgu; const float* lrstd;
    __device__ __forceinline__ void operator()(const Acc& acc, const Unit& u, int wr, int wc, int fr, int fq, LAS unsigned char*) const {
        asm volatile("" : "+v"(fr), "+v"(fq));
        const int j0 = (u.col0 >> 1) + 32 * wc + 8 * fq;
        const float* bp = bgu + (size_t)u.aux * 2048 + 2 * j0;
        f32x4 bb[4];
#pragma unroll
        for (int i = 0; i < 4; ++i) bb[i] = *(const f32x4*)(bp + 4 * i);
        float rsv[2][4];
#pragma unroll
        for (int ai = 0; ai < 2; ++ai)
#pragma unroll
            for (int m = 0; m < 4; ++m) { const int lr = EPI_ROW(ai, m); rsv[ai][m] = lr < u.nvalid ? lrstd[u.lbase + lr] : 0.f; }
#pragma unroll
        for (int ai = 0; ai < 2; ++ai)
#pragma unroll
            for (int m = 0; m < 4; ++m) { const int lr = EPI_ROW(ai, m);
                if (lr < u.nvalid) { const float rs = rsv[ai][m]; f32x4 o[2];
#pragma unroll
                    for (int n = 0; n < 2; ++n)
#pragma unroll
                        for (int i = 0; i < 4; ++i) { const int jj = 4 * n + i;
                            float g = acc[ai][0][m][n][i] * rs + bb[jj >> 1][(jj & 1) * 2];
                            float up = acc[ai][1][m][n][i] * rs + bb[jj >> 1][(jj & 1) * 2 + 1];
                            g = fminf(g, 7.0f); up = fminf(fmaxf(up, -7.0f), 7.0f);
                            o[n][i] = (up + 1.0f) * (g * sigmoidf_(1.702f * g)); }
                    *(u32x4*)(act + (size_t)(u.row0 + lr) * D + j0) = pack8(o[0], o[1]); } }
    }
};
struct EpiSwigluI8 {
    bf16_t* act; const float* bgu; const float* lrs; const float* cb;
    template <class Hook>
    __device__ __forceinline__ void operator()(const AccI& acc, const Unit& u, int wr, int wc, int fr, int fq, LAS unsigned char*, const Hook& hook) const {
        asm volatile("" : "+v"(fr), "+v"(fq));
        constexpr float QS = 127.0f / ACTQ_CLIP;
        const int j0 = (u.col0 >> 1) + 32 * wc + 8 * fq;
        const float* bp = bgu + (size_t)u.aux * 2048 + 2 * j0;
        const float sc = cb[(size_t)u.aux * 2048 + u.col0 + 32 * wc + 8 * fq];
        float rsv[2][4];
#pragma unroll
        for (int ai = 0; ai < 2; ++ai)
#pragma unroll
            for (int m = 0; m < 4; ++m) { const int lr = EPI_ROW(ai, m); rsv[ai][m] = lr < u.nvalid ? lrs[u.lbase + lr] : 0.f; }
        f32x4 bb[2][2];
#pragma unroll
        for (int n = 0; n < 2; ++n) { bb[n][0] = *(const f32x4*)(bp + 8 * n); bb[n][1] = *(const f32x4*)(bp + 8 * n + 4); }
        hook();
        f32x2 bg[2][2], bu[2][2];
#pragma unroll
        for (int n = 0; n < 2; ++n)
#pragma unroll
            for (int ip = 0; ip < 2; ++ip) { bg[n][ip] = (f32x2){bb[n][ip][0] * QS, bb[n][ip][2] * QS}; bu[n][ip] = (f32x2){bb[n][ip][1] + 1.0f, bb[n][ip][3] + 1.0f}; }
#pragma unroll
        for (int ai = 0; ai < 2; ++ai)
#pragma unroll
            for (int m = 0; m < 4; ++m) { const int lr = EPI_ROW(ai, m);
                if (lr < u.nvalid) { const float rss = rsv[ai][m] * sc, rsq = rss * QS; u32x2 pk;
#pragma unroll
                    for (int n = 0; n < 2; ++n) { f32x2 o[2];
#pragma unroll
                        for (int ip = 0; ip < 2; ++ip) {
                            f32x2 gq = (f32x2){(float)acc[ai][0][m][n][2 * ip], (float)acc[ai][0][m][n][2 * ip + 1]} * rsq + bg[n][ip];
                            f32x2 u1 = (f32x2){(float)acc[ai][1][m][n][2 * ip], (float)acc[ai][1][m][n][2 * ip + 1]} * rss + bu[n][ip];
                            gq[0] = fminf(gq[0], 7.0f * QS); gq[1] = fminf(gq[1], 7.0f * QS);
                            u1[0] = fminf(fmaxf(u1[0], -6.0f), 8.0f); u1[1] = fminf(fmaxf(u1[1], -6.0f), 8.0f);
                            f32x2 e = gq * (-1.702f * 1.4426950408889634f / QS);
                            e[0] = __builtin_amdgcn_exp2f(e[0]); e[1] = __builtin_amdgcn_exp2f(e[1]);
                            e = e + 1.0f;
                            const f32x2 r = (f32x2){__builtin_amdgcn_rcpf(e[0]), __builtin_amdgcn_rcpf(e[1])};
                            o[ip] = (u1 * gq) * r; }
                        const unsigned w = pack_i8x4(o[0][0], o[0][1], o[1][0], o[1][1]); if (n == 0) pk.x = w; else pk.y = w; }
                    *(u32x2*)((unsigned char*)act + (size_t)(u.row0 + lr) * D + j0) = pk; } }
    }
};
struct EpiDown {
    bf16_t* yb; const float* bd; const float* lgate; const float* cbd;
    __device__ __forceinline__ void operator()(const AccI& acc, const Unit& u, int wr, int wc, int fr, int fq, LAS unsigned char*) const {
        asm volatile("" : "+v"(fr), "+v"(fq));
        f32x4 bv[2][2], cs[2][2];
#pragma unroll
        for (int bj = 0; bj < 2; ++bj)
#pragma unroll
            for (int n = 0; n < 2; ++n) { bv[bj][n] = *(const f32x4*)(bd + (size_t)u.aux * D + u.col0 + EPI_COL(bj) + 4 * n); cs[bj][n] = *(const f32x4*)(cbd + (size_t)u.aux * D + u.col0 + EPI_COL(bj) + 4 * n) * (ACTQ_CLIP / 127.0f); }
        float gtv[2][4];
#pragma unroll
        for (int ai = 0; ai < 2; ++ai)
#pragma unroll
            for (int m = 0; m < 4; ++m) { const int lr = EPI_ROW(ai, m); gtv[ai][m] = lr < u.nvalid ? lgate[u.lbase + lr] : 0.f; }
#pragma unroll
        for (int ai = 0; ai < 2; ++ai)
#pragma unroll
            for (int m = 0; m < 4; ++m) { const int lr = EPI_ROW(ai, m);
                if (lr < u.nvalid) { const float gt = gtv[ai][m]; unsigned char* rowp = (unsigned char*)yb + (size_t)(u.row0 + lr) * D + u.col0;
#pragma unroll
                    for (int bj = 0; bj < 2; ++bj) { f32x4 y0, y1; u32x2 o;
#pragma unroll
                        for (int ip = 0; ip < 2; ++ip) {
                            const f32x2 a0 = (f32x2){(float)acc[ai][bj][m][0][2 * ip], (float)acc[ai][bj][m][0][2 * ip + 1]}, a1 = (f32x2){(float)acc[ai][bj][m][1][2 * ip], (float)acc[ai][bj][m][1][2 * ip + 1]};
                            const f32x2 r0 = (a0 * (f32x2){cs[bj][0][2 * ip], cs[bj][0][2 * ip + 1]} + (f32x2){bv[bj][0][2 * ip], bv[bj][0][2 * ip + 1]}) * gt;
                            const f32x2 r1 = (a1 * (f32x2){cs[bj][1][2 * ip], cs[bj][1][2 * ip + 1]} + (f32x2){bv[bj][1][2 * ip], bv[bj][1][2 * ip + 1]}) * gt;
                            y0[2 * ip] = r0[0]; y0[2 * ip + 1] = r0[1]; y1[2 * ip] = r1[0]; y1[2 * ip + 1] = r1[1]; }
                        int w0 = __builtin_amdgcn_cvt_pk_fp8_f32(y0[0], y0[1], 0, false); w0 = __builtin_amdgcn_cvt_pk_fp8_f32(y0[2], y0[3], w0, true);
                        int w1 = __builtin_amdgcn_cvt_pk_fp8_f32(y1[0], y1[1], 0, false); w1 = __builtin_amdgcn_cvt_pk_fp8_f32(y1[2], y1[3], w1, true);
                        o.x = (unsigned)w0; o.y = (unsigned)w1; *(u32x2*)(rowp + EPI_COL(bj)) = o; } } }
    }
};

struct GnKHook {
    static constexpr bool ON = true;
    const float* ssq;
    __device__ __forceinline__ void prepare(const Unit& u, LAS unsigned char* lds, int tid) const {
        if (tid < 256) { const f32x4* sp = (const f32x4*)(ssq + (size_t)(u.row0 + tid) * 16); float s[4];
#pragma unroll
            for (int g = 0; g < 4; ++g) { const f32x4 q = sp[g]; s[g] = rsqrtf(((q[0] + q[1]) + (q[2] + q[3])) * (1.0f / 256.0f) + EPS); }
            *(LAS f32x4*)(lds + XCH_OFF + tid * 16) = (f32x4){s[0] / s[1], s[1] / s[2], s[2] / s[3], s[3]}; }
    }
    template <class A> __device__ __forceinline__ void at(int t, A& acc, int wr, int fr, LAS unsigned char* lds) const {
        if (t == 4 || t == 8 || t == 12 || t == 16) { const int g = (t >> 2) - 1;
#pragma unroll
            for (int ai = 0; ai < 2; ++ai)
#pragma unroll
                for (int m = 0; m < 4; ++m) { const float r = ((const LAS float*)(lds + XCH_OFF))[(128 * ai + 64 * wr + 16 * m + fr) * 4 + g];
#pragma unroll
                    for (int bj = 0; bj < 2; ++bj)
#pragma unroll
                        for (int n = 0; n < 2; ++n) acc[ai][bj][m][n] = acc[ai][bj][m][n] * r; } }
    }
};
struct KvSched {
    int G, c; const char* MNB; const char* WK; const char* WV;
    __device__ __forceinline__ bool next(int i, Unit& u) const {
        const int L = i * G + c; if (L >= 64) return false;
        u.nvalid = 256; u.lbase = 0;
        if (L < 32) { const int pm = L >> 2, pn = L & 3; u.aux = 0; u.row0 = 256 * pm; u.col0 = 256 * pn; u.A = MNB + (size_t)pm * 256 * 1024; u.B = WK + (size_t)pn * 256 * 1024; }
        else { const int l2 = L - 32, pm = l2 >> 3, pn = l2 & 7; u.aux = 1; u.row0 = 256 * pm; u.col0 = 256 * pn; u.A = WV + (size_t)pm * 256 * 1024; u.B = MNB + (size_t)pn * 256 * 1024; }
        return true;
    }
    __device__ __forceinline__ void a_rows(const Unit&, const int (&)[2], int (&)[2][2]) const {}
    __device__ __forceinline__ void a_offs(const Unit&, const int (&RA)[2], const int (&CA)[2], int lda_b_, unsigned (&v)[2][2]) const {
#pragma unroll
        for (int h = 0; h < 2; ++h)
#pragma unroll
            for (int i = 0; i < 2; ++i) v[h][i] = (unsigned)((RA[i] + 128 * h) * lda_b_ + CA[i]);
    }
};
struct AttnSched {
    int G, c, mode; const char* A; const char* B;
    __device__ __forceinline__ bool next(int i, Unit& u) const {
        const int L = i * G + c; if (L >= 512) return false;
        const int b = L >> 6, h = (L >> 4) & 3, qt = L & 15;
        u.aux = 0; u.nvalid = 256; u.lbase = 0; u.row0 = b * SEQ + 256 * qt; u.col0 = 256 * h;
        if (mode == 2) { u.A = A + (size_t)u.row0 * D; u.B = B + (size_t)(256 * h) * D; return true; }
        u.A = A + ((size_t)u.row0 * D + 256 * h) * 2;
        u.B = mode == 0 ? B + ((size_t)(b * NMEM) * D + 256 * h) * 2 : B + ((size_t)(256 * h) * MT + b * NMEM) * 2;
        return true;
    }
    __device__ __forceinline__ void a_rows(const Unit&, const int (&)[2], int (&)[2][2]) const {}
    __device__ __forceinline__ void a_offs(const Unit&, const int (&RA)[2], const int (&CA)[2], int lda_b_, unsigned (&v)[2][2]) const {
#pragma unroll
        for (int h = 0; h < 2; ++h)
#pragma unroll
            for (int i = 0; i < 2; ++i) v[h][i] = (unsigned)((RA[i] + 128 * h) * lda_b_ + CA[i]);
    }
};
struct MoeSched {
    int G, c, npn, gather; const LAS int* tab; const char* A; const char* W; const int* ltok; size_t wstride; int ldb;
    __device__ __forceinline__ bool next(int i, Unit& u) const {
        const int total = tab[64 + 32]; int L;
        if ((G & 7) == 0) { const int per = (total + 7) >> 3, x = c & 7, lo = x * per, hi = (lo + per < total) ? lo + per : total; L = lo + (c >> 3) + (G >> 3) * i; if (L >= hi) return false; }
        else { L = i * G + c; if (L >= total) return false; }
        int e = 0;
#pragma unroll 1
        for (int k = 1; k < 32; ++k) e += (L >= tab[64 + k]) ? 1 : 0;
        e = __builtin_amdgcn_readfirstlane(e);
        const int ub = tab[64 + e], cnt = tab[e + 1] - tab[e], tiles = (cnt + 255) >> 8, idx = L - ub, rt = idx / npn, pn = idx - rt * npn; (void)tiles;
        u.aux = e; u.row0 = tab[e] + 256 * rt; u.col0 = 256 * pn; u.nvalid = cnt - 256 * rt; u.lbase = e * T + 256 * rt;
        u.A = gather ? A : A + (size_t)u.row0 * 1024;
        u.B = W + (size_t)e * wstride + (size_t)pn * 256 * ldb;
        return true;
    }
    __device__ __forceinline__ void a_rows(const Unit& u, const int (&RA)[2], int (&t)[2][2]) const {
#pragma unroll
        for (int h = 0; h < 2; ++h)
#pragma unroll
            for (int i = 0; i < 2; ++i) { const int lr = RA[i] + 128 * h; t[h][i] = lr < u.nvalid ? ltok[u.lbase + lr] : 0; }
    }
    __device__ __forceinline__ void a_offs(const Unit& u, const int (&RA)[2], const int (&CA)[2], int lda_b_, unsigned (&v)[2][2]) const {
#pragma unroll
        for (int h = 0; h < 2; ++h)
#pragma unroll
            for (int i = 0; i < 2; ++i) { const int lr = RA[i] + 128 * h;
                if (gather) { int tok = lr < u.nvalid ? ltok[u.lbase + lr] : 0; asm volatile("" : "+v"(tok)); v[h][i] = (unsigned)tok * (unsigned)lda_b_ + (unsigned)CA[i]; }
                else v[h][i] = (unsigned)(lr * lda_b_ + CA[i]); }
    }
};

#define XB_TMO      128
#define XB_XCNT(j)  (256  + 64 * (j))
#define XB_XSUB(j)  (1280 + 64 * (j))
#define XB_XGEN(j)  (2304 + 64 * (j))
#define XB_TOP      3328
#define XB_TOPGEN   3392
#define XCD_BAR_WORDS 3456
#define XB_SPIN_CAP (1u << 18)
__device__ __forceinline__ unsigned xb_ld(unsigned* p)              { return __hip_atomic_load(p, __ATOMIC_RELAXED, __HIP_MEMORY_SCOPE_AGENT); }
__device__ __forceinline__ unsigned xb_add(unsigned* p, unsigned v) { return __hip_atomic_fetch_add(p, v, __ATOMIC_RELAXED, __HIP_MEMORY_SCOPE_AGENT); }
__device__ __forceinline__ unsigned xb_xcc_id() { return (unsigned)__builtin_amdgcn_s_getreg((3 << 11) | 20) & 0xFu; }
#define XB_SPIN(cond, bar) do { unsigned _sp = 0; while (cond) { __builtin_amdgcn_s_sleep(1); \
    if ((++_sp & 255u) == 0u) { if (xb_ld(&(bar)[XB_TMO])) break; if (_sp > XB_SPIN_CAP) { atomicAdd(&(bar)[XB_TMO], 1u); break; } } } } while (0)
struct XcdBarrier { unsigned* bar; unsigned x; volatile LAS unsigned* st; };
__device__ __forceinline__ XcdBarrier xcd_barrier_post(unsigned* bar, volatile LAS unsigned* st) {
    XcdBarrier b; b.bar = bar; b.x = xb_xcc_id(); b.st = st;
    if (threadIdx.x == 0) (void)xb_add(&bar[XB_XCNT(b.x)], 1u);
    return b;
}
__device__ __forceinline__ void xcd_barrier_complete(unsigned* bar, unsigned x, unsigned& nloc, unsigned& nx) {
    const unsigned G = gridDim.x * gridDim.y * gridDim.z;
    unsigned sum, cnt, mine, sp = 0u;
    for (;;) {
        sum = 0u; cnt = 0u; mine = 0u;
#pragma unroll
        for (unsigned j = 0; j < 16; ++j) { const unsigned c = xb_ld(&bar[XB_XCNT(j)]); sum += c; cnt += (c > 0u) ? 1u : 0u; mine = (j == x) ? c : mine; }
        if (sum == G) break;
        __builtin_amdgcn_s_sleep(1);
        if ((++sp & 255u) == 0u) { if (xb_ld(&bar[XB_TMO])) break; if (sp > XB_SPIN_CAP) { atomicAdd(&bar[XB_TMO], 1u); break; } }
    }
    nloc = mine > 0u ? mine : 1u; nx = cnt > 0u ? cnt : 1u;
}
__device__ __forceinline__ void xcd_barrier(const XcdBarrier& b) {
    asm volatile("s_waitcnt vmcnt(0)" ::: "memory");
    __syncthreads();
    if (threadIdx.x == 0) {
        unsigned* bar = b.bar;
        __builtin_amdgcn_s_waitcnt(0);
        unsigned nloc = b.st[0], nx = b.st[1];
        if (nloc == 0u) { xcd_barrier_complete(bar, b.x, nloc, nx); b.st[0] = nloc; b.st[1] = nx; }
        const unsigned old = xb_add(&bar[XB_XSUB(b.x)], 1u);
        const unsigned gen = old / nloc;
        if (old + 1u == (gen + 1u) * nloc) {
            __builtin_amdgcn_fence(__ATOMIC_RELEASE, "agent");
            asm volatile("s_waitcnt vmcnt(0)" ::: "memory");
            const unsigned og = xb_add(&bar[XB_TOP], 1u);
            const unsigned tg = og / nx;
            if (og + 1u == (tg + 1u) * nx) xb_add(&bar[XB_TOPGEN], 1u);
            else XB_SPIN(xb_ld(&bar[XB_TOPGEN]) == tg, bar);
            __builtin_amdgcn_fence(__ATOMIC_ACQUIRE, "agent");
            xb_add(&bar[XB_XGEN(b.x)], 1u);
            asm volatile("s_waitcnt vmcnt(0)" ::: "memory");
        } else {
            XB_SPIN(xb_ld(&bar[XB_XGEN(b.x)]) == gen, bar);
            __builtin_amdgcn_fence(__ATOMIC_ACQUIRE, "agent");
            asm volatile("s_waitcnt vmcnt(0)" ::: "memory");
        }
    }
    __syncthreads();
}

struct Frame {
    LAS unsigned char* lds;
    unsigned* ctl;
    int tid, lane, wave, vcu, G;
    const float* in[31];
    float* out;
    unsigned char* ws;
};
#define WSP(type, off) ((type*)(F.ws + (off)))

template <class RowMap>
__device__ __forceinline__ void p0_tr_item(const float* W, int N, int k0, int n0, const float* kgain, float sc, bf16_t* dst, int Kdst, RowMap rm, LAS unsigned char* scr, int tid) {
    __syncthreads();
#pragma unroll
    for (int j = 0; j < 4; ++j) { const int f = tid + 512 * j, k = f >> 4, c = (f & 15) * 4;
        const f32x4 v = *(const f32x4*)(W + (size_t)(k0 + k) * N + n0 + c);
        const float g = (kgain ? kgain[k0 + k] : 1.0f) * sc;
#pragma unroll
        for (int q = 0; q < 4; ++q) ((LAS unsigned short*)scr)[(c + q) * 136 + k] = (unsigned short)f2bf(v[q] * g); }
    __syncthreads();
#pragma unroll
    for (int j = 0; j < 2; ++j) { const int ch = tid + 512 * j, n = ch >> 4, kc = ch & 15;
        const u32x4 o = *(const LAS u32x4*)(scr + n * 272 + kc * 16);
        *(u32x4*)(dst + (size_t)rm(n0 + n) * Kdst + k0 + kc * 8) = o; }
    __syncthreads();
}
struct RmId { static constexpr bool TILE_SCALE = false; int off; __device__ __forceinline__ int operator()(int n) const { return n + off; } };
struct RmGu { static constexpr bool TILE_SCALE = true; __device__ __forceinline__ int operator()(int n) const { const int j = n >> 1; return (j >> 7) * 256 + (n & 1) * 128 + (j & 127); } };

template <class RowMap>
__device__ __forceinline__ void p0_quant_item(const float* W, int ldw, int n0, const float* kgain, signed char* dst, float* cb, RowMap rm, LAS unsigned char* scr, int tid, const LAS float* lgain = nullptr) {
    asm volatile("" : "+v"(tid));
    const int i16 = tid & 15, c = i16 * 4, kg = tid >> 4, lane = tid & 63, w = tid >> 6;
    const float* Wp = W + n0 + c;
    const unsigned rb = (unsigned)(4 * kg) * (unsigned)ldw;
    constexpr int PF = 3;
    f32x4 v[8][4]; unsigned pk[8][4][2]; float mx[4] = {0.f, 0.f, 0.f, 0.f};
#pragma unroll
    for (int jj = 0; jj < 8 + PF; ++jj) {
        if (jj < 8) {
#pragma unroll
            for (int i = 0; i < 4; ++i) v[jj][i] = *(const f32x4*)(Wp + (rb + (unsigned)(128 * jj + i) * (unsigned)ldw)); }
        asm volatile("" ::: "memory");
        if (jj >= PF) { const int j = jj - PF;
            f32x4 g = (f32x4){1.f, 1.f, 1.f, 1.f};
            if (lgain) g = *(const LAS f32x4*)(lgain + 4 * kg + 128 * j); else if (kgain) g = *(const f32x4*)(kgain + 4 * kg + 128 * j);
#pragma unroll
            for (int i = 0; i < 4; ++i) { v[j][i] = v[j][i] * g[i];
#pragma unroll
                for (int q = 0; q < 4; ++q) mx[q] = fmaxf(mx[q], fabsf(v[j][i][q])); }
#pragma unroll
            for (int q = 0; q < 4; ++q) { pk[j][q][0] = cvt_pk_bf16(v[j][0][q], v[j][1][q]); pk[j][q][1] = cvt_pk_bf16(v[j][2][q], v[j][3][q]); } }
    }
#pragma unroll
    for (int q = 0; q < 4; ++q) { mx[q] = fmaxf(mx[q], __shfl_xor(mx[q], 16)); mx[q] = fmaxf(mx[q], __shfl_xor(mx[q], 32)); }
    LAS float* CMX = (LAS float*)(scr + 65536);
    if ((lane >> 4) == 0) *(LAS f32x4*)(CMX + w * 64 + c) = (f32x4){mx[0], mx[1], mx[2], mx[3]};
    __syncthreads();
    f32x4 cm = *(const LAS f32x4*)(CMX + c);
#pragma unroll
    for (int i = 1; i < 8; ++i) { const f32x4 o = *(const LAS f32x4*)(CMX + i * 64 + c); cm[0] = fmaxf(cm[0], o[0]); cm[1] = fmaxf(cm[1], o[1]); cm[2] = fmaxf(cm[2], o[2]); cm[3] = fmaxf(cm[3], o[3]); }
    if (RowMap::TILE_SCALE) {
        float m = fmaxf(fmaxf(cm[0], cm[1]), fmaxf(cm[2], cm[3]));
#pragma unroll
        for (int o = 1; o < 16; o <<= 1) m = fmaxf(m, __shfl_xor(m, o));
        cm = (f32x4){m, m, m, m}; }
    if (kg == 0) {
#pragma unroll
        for (int q = 0; q < 4; ++q) cb[rm(n0 + c + q)] = cm[q] * (1.0f / 127.0f); }
    constexpr float MAGIC = 12582912.0f;
#pragma unroll
    for (int q = 0; q < 4; ++q) { const float qs = cm[q] > 0.f ? 127.0f / cm[q] : 0.f;
        LAS unsigned char* rowp = scr + (c + q) * 1024;
#pragma unroll
        for (int j = 0; j < 8; ++j) {
            const unsigned f0 = __builtin_bit_cast(unsigned, fmaf(bflo(pk[j][q][0]), qs, MAGIC)), f1 = __builtin_bit_cast(unsigned, fmaf(bfhi(pk[j][q][0]), qs, MAGIC));
            const unsigned f2 = __builtin_bit_cast(unsigned, fmaf(bflo(pk[j][q][1]), qs, MAGIC)), f3 = __builtin_bit_cast(unsigned, fmaf(bfhi(pk[j][q][1]), qs, MAGIC));
            const unsigned wd = __builtin_amdgcn_perm(f1, f0, 0x0c0c0400u) | __builtin_amdgcn_perm(f3, f2, 0x04000c0cu);
            *(LAS unsigned*)(rowp + (((kg + 32 * j) ^ (i16 << 2)) << 2)) = wd; } }
    __syncthreads();
#pragma unroll
    for (int r = 0; r < 8; ++r) { const int n = 8 * w + r;
        const u32x4 o = *(const LAS u32x4*)(scr + n * 1024 + ((lane ^ ((n >> 2) & 15)) << 4));
        *(u32x4*)(dst + (size_t)rm(n0 + n) * 1024 + lane * 16) = o; }
}
__device__ __forceinline__ void p0_prologue(Frame& F) {
    LAS unsigned char* scr = F.lds;
    const int tid = F.tid;
    { LAS float* lg = (LAS float*)(scr + MISC_OFF + 512); for (int i = tid; i < 1024; i += 512) lg[i] = F.in[23][i]; }
    __syncthreads();
    constexpr int I_IN = 80, I_OUT = 16 * 16, I_Q = 16, I_KV = 32, I_O = 8 * 16, I_GU = 32 * 32, I_DN = 32 * 16;
    constexpr int NITEMS = I_IN + I_OUT + I_Q + I_KV + I_O + I_GU + I_DN;
    const bool rows_first = (F.vcu & 1) != 0;
    const int gw = F.vcu * 8 + F.wave, NGW = F.G * 8, lane = F.lane;
    for (int st_ = 0; st_ < 2; ++st_) {
    if ((st_ == 0) != rows_first) {
    for (int rep0_ = 0; rep0_ < ((REP0 & 1) ? 2 : 1); ++rep0_)
    for (int it = F.vcu; it < NITEMS; it += F.G) {
        int r = it; if ((REP0 & 4) && !(r >= I_IN + I_OUT + I_Q + I_KV + I_O && r < I_IN + I_OUT + I_Q + I_KV + I_O + I_GU) && rep0_) continue; if ((REP0 & 8) && !(r >= I_IN + I_OUT + I_Q + I_KV + I_O + I_GU) && rep0_) continue;
        if (r < I_IN) { const int nb = r; const int n0 = nb < 48 ? 64 * nb : 3088 + 64 * (nb - 48);
            p0_quant_item(F.in[3], 5136, n0, nullptr, (signed char*)(F.ws + WS_WIN), WSP(float, WS_CBIN), RmId{nb < 48 ? 0 : -16}, scr, tid); continue; } r -= I_IN;
        if (r < I_OUT) { const int kb = r / 16, nb = r % 16; p0_tr_item(F.in[17], 1024, 128 * kb, 64 * nb, kb < 8 ? F.in[9] : nullptr, 1.0f, WSP(bf16_t, WS_WOUT), 2048, RmId{0}, scr, tid); continue; } r -= I_OUT;
        if (r < I_Q) { p0_quant_item(F.in[20], 1024, 64 * r, F.in[18], (signed char*)(F.ws + WS_WQ), WSP(float, WS_CBQ), RmId{0}, scr, tid); continue; } r -= I_Q;
        if (r < I_KV) { const int nb = r; p0_quant_item(F.in[21], 2048, 64 * nb, nullptr, (signed char*)(F.ws + WS_WK), WSP(float, WS_CBKV), RmId{0}, scr, tid); continue; } r -= I_KV;
        if (r < I_O) { const int kb = r / 16, nb = r % 16; p0_tr_item(F.in[22], 1024, 128 * kb, 64 * nb, nullptr, 1.0f, WSP(bf16_t, WS_WO), 1024, RmId{0}, scr, tid); continue; } r -= I_O;
        if (r < I_GU) { const int e = r / 32, nb = r % 32;
            p0_quant_item(F.in[26] + (size_t)e * 1024 * 2048, 2048, 64 * nb, F.in[23], (signed char*)(F.ws + WS_WGU) + (size_t)e * 2048 * 1024, WSP(float, WS_CB) + (size_t)e * 2048, RmGu{}, scr, tid, (const LAS float*)(scr + MISC_OFF + 512)); continue; } r -= I_GU;
        { const int e = r / 16, nb = r % 16;
            p0_quant_item(F.in[28] + (size_t)e * 1024 * 1024, 1024, 64 * nb, nullptr, (signed char*)(F.ws + WS_WD) + (size_t)e * 1024 * 1024, WSP(float, WS_CBD) + (size_t)e * 1024, RmId{0}, scr, tid); }
    }
    { const int gt = F.vcu * 512 + tid, GT = F.G * 512;
      for (int i = gt; i < 32 * 1024; i += GT) { const int e = i >> 10, k = i & 1023; WSP(float, WS_WR)[i] = F.in[24][(size_t)k * 32 + e] * F.in[23][k]; } }
    for (int m = gw; m < MT; m += NGW) {
        const f32x4* xr = (const f32x4*)(F.in[1] + (size_t)m * D) + lane; const f32x4* gp = (const f32x4*)F.in[19] + lane;
        f32x4 v[4]; float s = 0.f;
#pragma unroll
        for (int j = 0; j < 4; ++j) { v[j] = xr[64 * j]; s += (v[j][0] * v[j][0] + v[j][1] * v[j][1]) + (v[j][2] * v[j][2] + v[j][3] * v[j][3]); }
        const float rs = rsqrtf(wave_sum(s) * (1.0f / D) + EPS);
        float mx = 0.f; const f32x4 gq[4] = {gp[0], gp[64], gp[128], gp[192]};
#pragma unroll
        for (int j = 0; j < 4; ++j) { v[j] = v[j] * rs * gq[j]; mx = fmaxf(mx, fmaxf(fmaxf(fabsf(v[j][0]), fabsf(v[j][1])), fmaxf(fabsf(v[j][2]), fabsf(v[j][3])))); }
#pragma unroll
        for (int o = 1; o < 64; o <<= 1) mx = fmaxf(mx, __shfl_xor(mx, o));
        const float qs = mx > 0.f ? 127.0f / mx : 0.f; unsigned* mq = (unsigned*)(F.ws + WS_MNB) + (size_t)m * 256 + lane;
#pragma unroll
        for (int j = 0; j < 4; ++j) { unsigned wd = 0;
#pragma unroll
            for (int i = 0; i < 4; ++i) wd |= ((unsigned)(int)rintf(v[j][i] * qs) & 0xffu) << (8 * i);
            mq[64 * j] = wd; }
        if (lane == 0) WSP(float, WS_MSC)[m] = mx * (1.0f / 127.0f);
    }
    } else {
    __syncthreads();
    LAS float* wdt = (LAS float*)F.lds;
    __syncthreads();
    for (int i = tid; i < 16 * 1024; i += 512) { const int o = i & 15, k = i >> 4; wdt[o * 1028 + k] = F.in[3][(size_t)k * 5136 + 3072 + o]; }
    __syncthreads();
    { const int ob = ((lane >> 5) & 1) * 8 + ((lane >> 4) & 1) * 4 + ((lane >> 3) & 1) * 2 + ((lane >> 2) & 1); const float dtb = F.in[6][ob];
      for (int rep1_ = 0; rep1_ < ((REP0 & 2) ? 2 : 1); ++rep1_)
#pragma unroll 1
      for (int m0 = gw; m0 < T; m0 += 2 * NGW) {
        int ln = lane; asm volatile("" : "+v"(ln));
        f32x4 v[2][4]; float s[2] = {0.f, 0.f}; const int m1 = (m0 + NGW < T) ? m0 + NGW : m0;
#pragma unroll
        for (int rr = 0; rr < 2; ++rr) { const int m = rr ? m1 : m0; const f32x4* xr = (const f32x4*)(F.in[0] + (size_t)m * D) + ln;
#pragma unroll
            for (int j = 0; j < 4; ++j) v[rr][j] = xr[64 * j]; }
#pragma unroll
        for (int rr = 0; rr < 2; ++rr)
#pragma unroll
            for (int j = 0; j < 4; ++j) s[rr] += (v[rr][j][0] * v[rr][j][0] + v[rr][j][1] * v[rr][j][1]) + (v[rr][j][2] * v[rr][j][2] + v[rr][j][3] * v[rr][j][3]);
        float rs[2], mx[2] = {0.f, 0.f};
        f32x2 vp[4][4];
        { const f32x4* gp = (const f32x4*)F.in[2] + ln;
          s[0] = wave_sum(s[0]); s[1] = wave_sum(s[1]); rs[0] = rsqrtf(s[0] * (1.0f / D) + EPS); rs[1] = rsqrtf(s[1] * (1.0f / D) + EPS);
          const f32x2 rs2 = (f32x2){rs[0], rs[1]};
#pragma unroll
          for (int j = 0; j < 4; ++j) { const f32x4 g = gp[64 * j];
#pragma unroll
              for (int i = 0; i < 4; ++i) { vp[j][i] = ((f32x2){v[0][j][i], v[1][j][i]} * rs2) * g[i]; mx[0] = fmaxf(mx[0], fabsf(vp[j][i][0])); mx[1] = fmaxf(mx[1], fabsf(vp[j][i][1])); } }
#pragma unroll
          for (int o = 1; o < 64; o <<= 1) { mx[0] = fmaxf(mx[0], __shfl_xor(mx[0], o)); mx[1] = fmaxf(mx[1], __shfl_xor(mx[1], o)); } }
#pragma unroll
        for (int rr = 0; rr < 2; ++rr) {
            const int m = rr ? m1 : m0;
            const float qs = mx[rr] > 0.f ? 127.0f / mx[rr] : 0.f; unsigned* hq = (unsigned*)(F.ws + WS_HN) + (size_t)m * 256 + ln;
#pragma unroll
            for (int j = 0; j < 4; ++j) { unsigned wd = 0;
#pragma unroll
                for (int i = 0; i < 4; ++i) wd |= ((unsigned)(int)rintf(vp[j][i][rr] * qs) & 0xffu) << (8 * i);
                hq[64 * j] = wd; }
            if (ln == 0) WSP(float, WS_RSC)[m] = mx[rr] * (1.0f / 127.0f); }
        float p[2][16];
#pragma unroll
        for (int o = 0; o < 16; ++o) { const LAS f32x4* wp = (const LAS f32x4*)(wdt + o * 1028) + ln; f32x2 acc = (f32x2){0.f, 0.f};
#pragma unroll
            for (int j = 0; j < 4; ++j) { const f32x4 w = wp[64 * j];
#pragma unroll
                for (int i = 0; i < 4; ++i) acc = vp[j][i] * w[i] + acc; }
            p[0][o] = acc[0]; p[1][o] = acc[1]; if ((o & 3) == 3) asm volatile("" ::: "memory"); }
#pragma unroll
        for (int rr = 0; rr < 2; ++rr) {
#pragma unroll
            for (int i = 0; i < 8; ++i) { const bool hi = (ln & 32) != 0; const float snd = hi ? p[rr][i] : p[rr][i + 8], kp = hi ? p[rr][i + 8] : p[rr][i]; p[rr][i] = kp + __shfl_xor(snd, 32); }
#pragma unroll
            for (int i = 0; i < 4; ++i) { const bool hi = (ln & 16) != 0; const float snd = hi ? p[rr][i] : p[rr][i + 4], kp = hi ? p[rr][i + 4] : p[rr][i]; p[rr][i] = kp + __shfl_xor(snd, 16); }
#pragma unroll
            for (int i = 0; i < 2; ++i) { const bool hi = (ln & 8) != 0; const float snd = hi ? p[rr][i] : p[rr][i + 2], kp = hi ? p[rr][i + 2] : p[rr][i]; p[rr][i] = kp + __shfl_xor(snd, 8); }
            { const bool hi = (ln & 4) != 0; const float snd = hi ? p[rr][0] : p[rr][1], kp = hi ? p[rr][1] : p[rr][0]; p[rr][0] = kp + __shfl_xor(snd, 4); }
            p[rr][0] += __shfl_xor(p[rr][0], 2); p[rr][0] += __shfl_xor(p[rr][0], 1);
            if ((ln & 3) == 0) WSP(float, WS_DTV)[(size_t)(rr ? m1 : m0) * 16 + ob] = softplusf_(p[rr][0] + dtb);
        }
      }
    }
    __syncthreads();
    }
    }
    __syncthreads();
}

__device__ __forceinline__ void p2_conv(Frame& F) {
    const bf16_t* proj = WSP(bf16_t, WS_PROJ); bf16_t* cv = WSP(bf16_t, WS_CV);
    for (int cidx = F.vcu; cidx < T / 64; cidx += F.G) {
        const int t0 = cidx * 64, cin = cidx & 63;
        for (int task = F.tid; task < 1024; task += 512) {
            const int v = task % 256, sub = task / 256, ch0 = 8 * v; const bool ssd = true;
            const float* wsrc = ssd ? F.in[4] + ch0 : F.in[10] + (ch0 - 2048); const int wn = ssd ? 2048 : 1024;
            const float* bsrc = ssd ? F.in[5] + ch0 : F.in[11] + (ch0 - 2048);
            float w[4][8], bias[8];
#pragma unroll
            for (int k = 0; k < 4; ++k) { const f32x4 a = *(const f32x4*)(wsrc + (size_t)k * wn), b = *(const f32x4*)(wsrc + (size_t)k * wn + 4);
                w[k][0] = a[0]; w[k][1] = a[1]; w[k][2] = a[2]; w[k][3] = a[3]; w[k][4] = b[0]; w[k][5] = b[1]; w[k][6] = b[2]; w[k][7] = b[3]; }
            { const f32x4 a = *(const f32x4*)bsrc, b = *(const f32x4*)(bsrc + 4); bias[0] = a[0]; bias[1] = a[1]; bias[2] = a[2]; bias[3] = a[3]; bias[4] = b[0]; bias[5] = b[1]; bias[6] = b[2]; bias[7] = b[3]; }
            const int ts = t0 + 16 * sub;
            const bf16_t* src = proj + (size_t)ts * NPROJ + PC_X + ch0;
            const bool first = (cin == 0 && sub == 0);
            u32x4 rw[19];
#pragma unroll
            for (int i = 0; i < 19; ++i) rw[i] = (i < 3 && first) ? (u32x4){0u, 0u, 0u, 0u} : *(const u32x4*)(src + (ptrdiff_t)(i - 3) * NPROJ);
#pragma unroll
            for (int r = 0; r < 16; ++r) { float y[8];
#pragma unroll
                for (int j = 0; j < 4; ++j) {
                    float a0 = bias[2 * j] + w[0][2 * j] * bflo(rw[r][j]) + w[1][2 * j] * bflo(rw[r + 1][j]) + w[2][2 * j] * bflo(rw[r + 2][j]) + w[3][2 * j] * bflo(rw[r + 3][j]);
                    float a1 = bias[2 * j + 1] + w[0][2 * j + 1] * bfhi(rw[r][j]) + w[1][2 * j + 1] * bfhi(rw[r + 1][j]) + w[2][2 * j + 1] * bfhi(rw[r + 2][j]) + w[3][2 * j + 1] * bfhi(rw[r + 3][j]);
                    y[2 * j] = ssd ? siluf_(a0) : a0; y[2 * j + 1] = ssd ? siluf_(a1) : a1; }
                u32x4 o; o.x = cvt_pk_bf16(y[0], y[1]); o.y = cvt_pk_bf16(y[2], y[3]); o.z = cvt_pk_bf16(y[4], y[5]); o.w = cvt_pk_bf16(y[6], y[7]);
                *(u32x4*)(cv + (size_t)(ts + r) * NCV + ch0) = o;
            }
        }
#pragma unroll
        for (int hh = 0; hh < 2; ++hh) { const int h = 2 * F.wave + hh; const float a = -__expf(F.in[7][h]);
            float val = WSP(float, WS_DTV)[(size_t)(t0 + F.lane) * 16 + h] * a;
#pragma unroll
            for (int o = 1; o < 64; o <<= 1) { const float up = __shfl_up(val, o); if (F.lane >= o) val += up; }
            WSP(float, WS_ACS)[(size_t)(t0 + F.lane) * 16 + h] = val; }
    }
}

__device__ __forceinline__ f32x4 zero4() { f32x4 z = (f32x4){0.f, 0.f, 0.f, 0.f}; asm volatile("" : "+v"(z)); return z; }
typedef short s16x4 __attribute__((ext_vector_type(4)));
__device__ __forceinline__ bf16x8 ldsfrag_tr(const LAS unsigned char* base, int kbase, int c0, int pitch_b, int lane) {
    const int j = lane & 15, fq = lane >> 4, q = j >> 2, pp = j & 3;
    const LAS unsigned char* a = base + (kbase + 8 * fq + q) * pitch_b + (c0 + 4 * pp) * 2;
    const s16x4 lo = __builtin_amdgcn_ds_read_tr16_b64_v4i16((LAS s16x4*)a);
    const s16x4 hi = __builtin_amdgcn_ds_read_tr16_b64_v4i16((LAS s16x4*)(a + 4 * pitch_b));
    return (bf16x8){lo[0], lo[1], lo[2], lo[3], hi[0], hi[1], hi[2], hi[3]};
}
__device__ __forceinline__ bf16x8 ldsfrag(const LAS unsigned char* base, int row, int pitch_b, int kbyte) { return *(const LAS bf16x8*)(base + row * pitch_b + kbyte); }

#define WG_BAR() do { asm volatile("s_waitcnt lgkmcnt(0)" ::: "memory"); __builtin_amdgcn_s_barrier(); asm volatile("" ::: "memory"); } while (0)
__device__ __forceinline__ void p3_ssd_unit(Frame& F, int b, int h) {
    constexpr int XO = 0, XW = 9216, BMo = 18432, CMo = 35840, MMo = 53248, STo = 62464, VEC = 79872;
    constexpr int P72 = 144, P136 = 272;
    LAS unsigned char* L = F.lds;
    LAS float* vss = (LAS float*)(L + VEC) + 192;
    int lane_ = F.lane; asm volatile("" : "+v"(lane_));
    const int lane = lane_, w = F.wave, tid = w * 64 + lane, fr = lane & 15, fq = lane >> 4, g = h >> 2;
    const bf16_t* cv = WSP(bf16_t, WS_CV); const bf16_t* proj = WSP(bf16_t, WS_PROJ); bf16_t* ycat = WSP(bf16_t, WS_YCAT);
    const float* dtv = WSP(float, WS_DTV); const float* acsg = WSP(float, WS_ACS); float* ssq = WSP(float, WS_SSQ);
    const float Dh = F.in[8][h];
    for (int i = tid; i < (9216 + 17408) / 4; i += 512) ((LAS unsigned*)(L + MMo))[i] = 0u;
    f32x4 sacc[4];
#pragma unroll
    for (int i = 0; i < 4; ++i) sacc[i] = (f32x4){0.f, 0.f, 0.f, 0.f};
    const int lt = w >> 1, ptb = 2 * (w & 1);
    float gmask[2][4];
#pragma unroll
    for (int q2 = 0; q2 < 2; ++q2) { const int q = 2 * w + q2, it = q >> 2, jt = q & 3;
#pragma unroll
        for (int r = 0; r < 4; ++r) gmask[q2][r] = (16 * jt + 4 * fq + r <= 16 * it + fr) ? 1.0f : 0.0f; }
    const int sl = tid >> 3, spc = tid & 7;
    u32x4 pxv, pbv[2], pcv[2]; u32x2 pzz[2]; float pdl, pal, pa63;
#define SSD_LOAD(c_) do { const int t0_ = b * SEQ + 64 * (c_); \
        pxv = *(const u32x4*)(cv + (size_t)(t0_ + sl) * NCV + h * 64 + 8 * spc); \
        pa63 = acsg[(size_t)(t0_ + 63) * 16 + h]; pdl = dtv[(size_t)(t0_ + sl) * 16 + h]; pal = acsg[(size_t)(t0_ + sl) * 16 + h]; \
        _Pragma("unroll") for (int jj = 0; jj < 2; ++jj) { const int idx = tid + 512 * jj, l2 = idx >> 4, nc = idx & 15; \
            pbv[jj] = *(const u32x4*)(cv + (size_t)(t0_ + l2) * NCV + 1024 + g * 128 + 8 * nc); pcv[jj] = *(const u32x4*)(cv + (size_t)(t0_ + l2) * NCV + 1536 + g * 128 + 8 * nc); } \
        _Pragma("unroll") for (int pp = 0; pp < 2; ++pp) pzz[pp] = *(const u32x2*)(proj + (size_t)(t0_ + 16 * lt + fr) * NPROJ + h * 64 + 16 * (ptb + pp) + 4 * fq); } while (0)
    constexpr int DB2 = 81920, VEC2 = 135168;
    float dec_n; u32x2 zn0, zn1;
    auto stage = [&](const int pb, const int vb) __attribute__((always_inline)) {
        LAS float* sdt = (LAS float*)(L + vb); LAS float* sacs = sdt + 64; LAS float* sea = sdt + 128;
        dec_n = __expf(pa63); zn0 = pzz[0]; zn1 = pzz[1];
        asm volatile("" : "+v"(dec_n), "+v"(zn0), "+v"(zn1));
        const float wl = pdl * __expf(pa63 - pal);
        if (spc == 0) { sdt[sl] = pdl; sacs[sl] = pal; sea[sl] = __expf(pal); }
        *(LAS u32x4*)(L + pb + XO + sl * P72 + 16 * spc) = pxv;
        u32x4 xw; xw.x = cvt_pk_bf16(bflo(pxv.x) * wl, bfhi(pxv.x) * wl); xw.y = cvt_pk_bf16(bflo(pxv.y) * wl, bfhi(pxv.y) * wl); xw.z = cvt_pk_bf16(bflo(pxv.z) * wl, bfhi(pxv.z) * wl); xw.w = cvt_pk_bf16(bflo(pxv.w) * wl, bfhi(pxv.w) * wl);
        *(LAS u32x4*)(L + pb + XW + sl * P72 + 16 * spc) = xw;
#pragma unroll
        for (int jj = 0; jj < 2; ++jj) { const int idx = tid + 512 * jj, l2 = idx >> 4, nc = idx & 15;
            *(LAS u32x4*)(L + pb + BMo + l2 * P136 + 16 * nc) = pbv[jj]; *(LAS u32x4*)(L + pb + CMo + l2 * P136 + 16 * nc) = pcv[jj]; } };
    SSD_LOAD(0);
    __syncthreads();
    stage(0, VEC);
    WG_BAR();
    for (int c = 0; c < 64; ++c) {
        const int t0 = b * SEQ + 64 * c;
        if (c + 1 < 64) SSD_LOAD(c + 1);
        const int PB = (c & 1) ? DB2 : 0;
        LAS float* vdt = (LAS float*)(L + ((c & 1) ? VEC2 : VEC)); LAS float* vacs = vdt + 64; LAS float* vea = vdt + 128;
        const float dec = dec_n; const u32x2 zc0 = zn0, zc1 = zn1;
        bf16x8 cfr[4];
#pragma unroll
        for (int kk = 0; kk < 4; ++kk) cfr[kk] = ldsfrag(L + PB + CMo, 16 * lt + fr, P136, 64 * kk + 16 * fq);
#pragma unroll
        for (int q2 = 0; q2 < 2; ++q2) { const int q = 2 * w + q2, it = q >> 2, jt = q & 3;
            if (jt <= it) { f32x4 a4 = zero4();
#pragma unroll
                for (int kk = 0; kk < 4; ++kk) a4 = __builtin_amdgcn_mfma_f32_16x16x32_bf16(ldsfrag(L + PB + BMo, 16 * jt + fr, P136, 64 * kk + 16 * fq), cfr[kk], a4, 0, 0, 0);
                const int l = 16 * it + fr, s0 = 16 * jt + 4 * fq; const float al = vacs[l]; float mv[4];
                const f32x4 as4 = *(const LAS f32x4*)(vacs + s0), dt4 = *(const LAS f32x4*)(vdt + s0);
#pragma unroll
                for (int r = 0; r < 4; ++r) mv[r] = a4[r] * (__expf(fminf(al - as4[r], 0.f)) * dt4[r]) * gmask[q2][r];
                u32x2 o; o.x = cvt_pk_bf16(mv[0], mv[1]); o.y = cvt_pk_bf16(mv[2], mv[3]);
                *(LAS u32x2*)(L + MMo + l * P72 + 2 * s0) = o; } }
        f32x4 yacc[2];
#pragma unroll
        for (int pp = 0; pp < 2; ++pp) { const int pt = ptb + pp; f32x4 a4 = zero4();
#pragma unroll
            for (int kk = 0; kk < 4; ++kk) a4 = __builtin_amdgcn_mfma_f32_16x16x32_bf16(ldsfrag(L + STo, 16 * pt + fr, P136, 64 * kk + 16 * fq), cfr[kk], a4, 0, 0, 0);
            yacc[pp] = a4 * vea[16 * lt + fr]; }
        WG_BAR();
        float sq = 0.f;
        { const int l = 16 * lt + fr; const size_t row = (size_t)(t0 + l);
          bf16x8 mfr[2];
#pragma unroll
          for (int kk = 0; kk < 2; ++kk) if (kk == 0 || lt >= 2) mfr[kk] = ldsfrag(L + MMo, 16 * lt + fr, P72, 64 * kk + 16 * fq);
#pragma unroll
          for (int pp = 0; pp < 2; ++pp) { const int pt = ptb + pp; f32x4 a4 = yacc[pp];
#pragma unroll
              for (int kk = 0; kk < 2; ++kk) if (kk == 0 || lt >= 2) a4 = __builtin_amdgcn_mfma_f32_16x16x32_bf16(ldsfrag_tr(L + PB + XO, 32 * kk, 16 * pt, P72, lane), mfr[kk], a4, 0, 0, 0);
              const int p0 = 16 * pt + 4 * fq;
              const u32x2 zz = pp ? zc1 : zc0; const u32x2 xx = *(const LAS u32x2*)(L + PB + XO + l * P72 + 2 * p0);
              const float z[4] = {bflo(zz.x), bfhi(zz.x), bflo(zz.y), bfhi(zz.y)}; const float xv[4] = {bflo(xx.x), bfhi(xx.x), bflo(xx.y), bfhi(xx.y)}; float uv[4];
#pragma unroll
              for (int r = 0; r < 4; ++r) { const float y = a4[r] + xv[r] * Dh; uv[r] = y * siluf_(z[r]); sq += uv[r] * uv[r]; }
              u32x2 o; o.x = cvt_pk_bf16(uv[0], uv[1]); o.y = cvt_pk_bf16(uv[2], uv[3]);
              *(u32x2*)(ycat + row * 2048 + h * 64 + p0) = o; }
          sq += __shfl_xor(sq, 16); sq += __shfl_xor(sq, 32);
          if (fq == 0) vss[(w & 1) * 64 + l] = sq; }
        { bf16x8 bt[2];
#pragma unroll
          for (int kk = 0; kk < 2; ++kk) bt[kk] = ldsfrag_tr(L + PB + BMo, 32 * kk, 16 * w, P136, lane);
#pragma unroll
          for (int pt = 0; pt < 4; ++pt) { f32x4 a4 = sacc[pt] * dec;
#pragma unroll
              for (int kk = 0; kk < 2; ++kk) a4 = __builtin_amdgcn_mfma_f32_16x16x32_bf16(bt[kk], ldsfrag_tr(L + PB + XW, 32 * kk, 16 * pt, P72, lane), a4, 0, 0, 0);
              sacc[pt] = a4;
              u32x2 o; o.x = cvt_pk_bf16(a4[0], a4[1]); o.y = cvt_pk_bf16(a4[2], a4[3]);
              *(LAS u32x2*)(L + STo + (16 * pt + fr) * P136 + 2 * (16 * w + 4 * fq)) = o; } }
        if (c + 1 < 64) stage((c & 1) ? 0 : DB2, (c & 1) ? VEC : VEC2);
        WG_BAR();
        if (tid < 64) ssq[(size_t)(t0 + tid) * 16 + h] = vss[tid] + vss[64 + tid];
    }
#undef SSD_LOAD
    __syncthreads();
}

__device__ __forceinline__ void p3_lru_unit(Frame& F, int b, int jb) {
    constexpr int AC = 0, WT = 9216, ALo = 27648, ULo = 44032; constexpr int P72 = 144;
    LAS unsigned char* L = F.lds;
    LAS float* AL = (LAS float*)(L + ALo); LAS float* UL = (LAS float*)(L + ULo); LAS float* SEG = (LAS float*)(L + 60416);
    int lane_ = F.lane; asm volatile("" : "+v"(lane_));
    const int lane = lane_, w = F.wave, tid = w * 64 + lane, fr = lane & 15, fq = lane >> 4;
    const bf16_t* cv = WSP(bf16_t, WS_CV); const bf16_t* proj = WSP(bf16_t, WS_PROJ); bf16_t* ycat = WSP(bf16_t, WS_YCAT);
    for (int i = tid; i < 8192; i += 512) { const int o = i & 127, ii = i >> 7; const float v = o < 64 ? F.in[12][((size_t)jb * 64 + ii) * 64 + o] : F.in[14][((size_t)jb * 64 + ii) * 64 + (o - 64)];
        ((LAS unsigned short*)(L + WT))[o * 72 + ii] = (unsigned short)f2bf(v); }
    float cba[2][4], cbx[2][4], csp[2][4];
#pragma unroll
    for (int pp = 0; pp < 2; ++pp) { const int ot = (2 * w + pp) & 3;
#pragma unroll
        for (int r = 0; r < 4; ++r) { const int ch = jb * 64 + 16 * ot + 4 * fq + r; cba[pp][r] = F.in[13][ch]; cbx[pp][r] = F.in[15][ch]; csp[pp][r] = -8.0f * log1pf(__expf(-F.in[16][ch])); } }
    float hstate = 0.f;
    const int l = tid >> 3, cc = tid & 7;
    __syncthreads();
    bf16x8 wfa[2][2], wfx[2][2];
#pragma unroll
    for (int pp = 0; pp < 2; ++pp) { const int ot = (2 * w + pp) & 3;
#pragma unroll
        for (int kk = 0; kk < 2; ++kk) { wfa[pp][kk] = ldsfrag(L + WT, 16 * ot + fr, P72, 64 * kk + 16 * fq); wfx[pp][kk] = ldsfrag(L + WT, 64 + 16 * ot + fr, P72, 64 * kk + 16 * fq); } }
    float cw[4][8], cbias[8];
    { const float* wsrc = F.in[10] + jb * 64 + 8 * cc; const float* bsrc = F.in[11] + jb * 64 + 8 * cc;
#pragma unroll
      for (int k = 0; k < 4; ++k) { const f32x4 a = *(const f32x4*)(wsrc + (size_t)k * 1024), c4 = *(const f32x4*)(wsrc + (size_t)k * 1024 + 4);
          cw[k][0] = a[0]; cw[k][1] = a[1]; cw[k][2] = a[2]; cw[k][3] = a[3]; cw[k][4] = c4[0]; cw[k][5] = c4[1]; cw[k][6] = c4[2]; cw[k][7] = c4[3]; }
      const f32x4 a = *(const f32x4*)bsrc, c4 = *(const f32x4*)(bsrc + 4); cbias[0] = a[0]; cbias[1] = a[1]; cbias[2] = a[2]; cbias[3] = a[3]; cbias[4] = c4[0]; cbias[5] = c4[1]; cbias[6] = c4[2]; cbias[7] = c4[3]; }
    u32x4 prw[4], pgv;
#define LRU_LOAD(t_) do { const int t0_ = b * SEQ + 64 * (t_); \
        _Pragma("unroll") for (int i_ = 0; i_ < 4; ++i_) prw[i_] = ((t_) == 0 && l + i_ < 3) ? (u32x4){0u, 0u, 0u, 0u} : *(const u32x4*)(proj + (size_t)(t0_ + l + i_ - 3) * NPROJ + PC_XR + jb * 64 + 8 * cc); \
        pgv = *(const u32x4*)(proj + (size_t)(t0_ + l) * NPROJ + PC_GR + jb * 64 + 8 * cc); } while (0)
    constexpr int AC2 = 64512, AL2o = 73728, UL2o = 90112;
    u32x4 gv_n;
    auto stage = [&](const int aco) __attribute__((always_inline)) { u32x4 pxv; float y[8];
        gv_n = pgv;
#pragma unroll
        for (int j = 0; j < 4; ++j) {
            y[2 * j] = cbias[2 * j] + cw[0][2 * j] * bflo(prw[0][j]) + cw[1][2 * j] * bflo(prw[1][j]) + cw[2][2 * j] * bflo(prw[2][j]) + cw[3][2 * j] * bflo(prw[3][j]);
            y[2 * j + 1] = cbias[2 * j + 1] + cw[0][2 * j + 1] * bfhi(prw[0][j]) + cw[1][2 * j + 1] * bfhi(prw[1][j]) + cw[2][2 * j + 1] * bfhi(prw[2][j]) + cw[3][2 * j + 1] * bfhi(prw[3][j]); }
        pxv.x = cvt_pk_bf16(y[0], y[1]); pxv.y = cvt_pk_bf16(y[2], y[3]); pxv.z = cvt_pk_bf16(y[4], y[5]); pxv.w = cvt_pk_bf16(y[6], y[7]);
        *(LAS u32x4*)(L + aco + l * P72 + 16 * cc) = pxv; };
    LRU_LOAD(0);
    __syncthreads();
    stage(AC);
    WG_BAR();
    for (int tile = 0; tile < 64; ++tile) {
        const int t0 = b * SEQ + 64 * tile;
        if (tile + 1 < 64) LRU_LOAD(tile + 1);
        const u32x4 gv = gv_n;
        const int aco = (tile & 1) ? AC2 : AC;
        LAS float* ALp = (tile & 1) ? (LAS float*)(L + AL2o) : AL; LAS float* ULp = (tile & 1) ? (LAS float*)(L + UL2o) : UL;
#pragma unroll
        for (int pp = 0; pp < 2; ++pp) { const int pi = 2 * w + pp, tt = pi >> 2, ot = pi & 3; f32x4 aa = zero4(), ax = zero4();
#pragma unroll
            for (int kk = 0; kk < 2; ++kk) { const bf16x8 bfr = ldsfrag(L + aco, 16 * tt + fr, P72, 64 * kk + 16 * fq);
                aa = __builtin_amdgcn_mfma_f32_16x16x32_bf16(wfa[pp][kk], bfr, aa, 0, 0, 0);
                ax = __builtin_amdgcn_mfma_f32_16x16x32_bf16(wfx[pp][kk], bfr, ax, 0, 0, 0); }
            const int t = 16 * tt + fr, ch0 = 16 * ot + 4 * fq; f32x4 av, uv;
#pragma unroll
            for (int r = 0; r < 4; ++r) { const float rr = sigmoidf_(aa[r] + cba[pp][r]), ii = sigmoidf_(ax[r] + cbx[pp][r]); const float la = csp[pp][r] * rr;
                const float xc = bf2f(((const LAS unsigned short*)(L + aco))[t * 72 + ch0 + r]);
                const float a = __expf(la); av[r] = a; uv[r] = xc * ii * __builtin_amdgcn_sqrtf(fmaxf(fmaf(-a, a, 1.0f), 0.f)); }
            *(LAS f32x4*)(ALp + t * 64 + ch0) = av; *(LAS f32x4*)(ULp + t * 64 + ch0) = uv; }
        WG_BAR();
        float hreg[8], preg[8];
        { float hl = 0.f, pl = 1.f;
#pragma unroll
          for (int i = 0; i < 8; ++i) { const int t = 8 * w + i; const float a = ALp[t * 64 + lane], u = ULp[t * 64 + lane]; hl = a * hl + u; pl *= a; hreg[i] = hl; preg[i] = pl; }
          SEG[w * 64 + lane] = pl; SEG[512 + w * 64 + lane] = hl; }
        if (tile + 1 < 64) stage((tile & 1) ? AC : AC2);
        WG_BAR();
        { float c = hstate, cin = 0.f;
#pragma unroll
          for (int v = 0; v < 8; ++v) { if (v == w) cin = c; c = SEG[v * 64 + lane] * c + SEG[512 + v * 64 + lane]; }
          hstate = c;
#pragma unroll
          for (int i = 0; i < 8; ++i) ULp[(8 * w + i) * 64 + lane] = fmaf(preg[i], cin, hreg[i]); }
        asm volatile("s_waitcnt lgkmcnt(0)" ::: "memory");
        { const f32x4 h0 = *(const LAS f32x4*)(ULp + l * 64 + 8 * cc), h1 = *(const LAS f32x4*)(ULp + l * 64 + 8 * cc + 4);
          u32x4 o;
          o.x = cvt_pk_bf16(h0[0] * gelu_tanhf_(bflo(gv.x)), h0[1] * gelu_tanhf_(bfhi(gv.x))); o.y = cvt_pk_bf16(h0[2] * gelu_tanhf_(bflo(gv.y)), h0[3] * gelu_tanhf_(bfhi(gv.y)));
          o.z = cvt_pk_bf16(h1[0] * gelu_tanhf_(bflo(gv.z)), h1[1] * gelu_tanhf_(bfhi(gv.z))); o.w = cvt_pk_bf16(h1[2] * gelu_tanhf_(bflo(gv.w)), h1[3] * gelu_tanhf_(bfhi(gv.w)));
          *(u32x4*)(ycat + (size_t)(t0 + l) * 2048 + 1024 + jb * 64 + 8 * cc) = o; }
    }
#undef LRU_LOAD
    __syncthreads();
}

__device__ __forceinline__ void p4_fixup(Frame& F) {
    const int gw = F.vcu * 8 + F.wave, NGW = F.G * 8, lane = F.lane;
    bf16_t* ycat = WSP(bf16_t, WS_YCAT); const float* ssq = WSP(float, WS_SSQ);
    for (int m = gw; m < T; m += NGW) {
#pragma unroll
        for (int jj = 0; jj < 2; ++jj) { const int col = 512 * jj + 8 * lane, g = col >> 8;
            const f32x4 s4 = *(const f32x4*)(ssq + (size_t)m * 16 + 4 * g);
            const float rs = rsqrtf(((s4[0] + s4[1]) + (s4[2] + s4[3])) * (1.0f / 256.0f) + EPS);
            u32x4* p = (u32x4*)(ycat + (size_t)m * 2048 + col); const u32x4 v = *p;
            const f32x4 g0 = *(const f32x4*)(F.in[9] + col), g1 = *(const f32x4*)(F.in[9] + col + 4);
            u32x4 o; o.x = cvt_pk_bf16(bflo(v.x) * rs * g0[0], bfhi(v.x) * rs * g0[1]); o.y = cvt_pk_bf16(bflo(v.y) * rs * g0[2], bfhi(v.y) * rs * g0[3]);
            o.z = cvt_pk_bf16(bflo(v.z) * rs * g1[0], bfhi(v.z) * rs * g1[1]); o.w = cvt_pk_bf16(bflo(v.w) * rs * g1[2], bfhi(v.w) * rs * g1[3]);
            *p = o; }
    }
}

__device__ __forceinline__ void p10_router(Frame& F) {
    LAS float* HT = (LAS float*)F.lds; LAS float* WTt = HT + 128 * 65; LAS float* LG = WTt + 64 * 32; LAS unsigned* SEL = (LAS unsigned*)(LG + 128 * 33); LAS float* RS = (LAS float*)(SEL + 128); LAS int* WBASE = (LAS int*)(RS + 128); LAS float* QS = (LAS float*)(WBASE + 32);
    const int tid = F.tid; const bf16_t* h2 = WSP(bf16_t, WS_H); const float* wr = WSP(float, WS_WR); const float* ss2 = WSP(float, WS_SS2);
    int* ltok = WSP(int, WS_LTOK); float* lgate = WSP(float, WS_LGATE); float* lrstd = WSP(float, WS_LRSTD); int* pair = WSP(int, WS_PAIR);
    for (int blk = F.vcu; blk < T / 128; blk += F.G) {
        const int tb = blk * 128; const int tt = tid >> 2, eq = tid & 3;
        if (tid < 128) { const f32x4* sp = (const f32x4*)(ss2 + (size_t)(tb + tid) * 16); const f32x4 s0 = sp[0], s1 = sp[1], s2 = sp[2], s3 = sp[3];
            const float tot = ((s0[0] + s0[1]) + (s0[2] + s0[3])) + ((s1[0] + s1[1]) + (s1[2] + s1[3])) + ((s2[0] + s2[1]) + (s2[2] + s2[3])) + ((s3[0] + s3[1]) + (s3[2] + s3[3]));
            RS[tid] = rsqrtf(tot * (1.0f / D) + EPS); }
        typedef float f32x16 __attribute__((ext_vector_type(16)));
        f32x16 lacc;
#pragma unroll
        for (int i = 0; i < 16; ++i) lacc[i] = 0.f;
        const int mg = F.wave & 3, kh = F.wave >> 2, li = F.lane & 31, lk = F.lane >> 5;
        f32x4 ph[4]; float pw[4];
#define RT_LOAD(k0_) do { _Pragma("unroll") for (int j = 0; j < 4; ++j) { const int f = tid + 512 * j; { const u32x2 hw_ = *(const u32x2*)(h2 + (size_t)(tb + (f >> 4)) * D + (k0_) + (f & 15) * 4); ph[j] = (f32x4){bflo(hw_.x), bfhi(hw_.x), bflo(hw_.y), bfhi(hw_.y)}; } pw[j] = wr[(size_t)(f >> 6) * D + (k0_) + (f & 63)]; } } while (0)
        RT_LOAD(0);
        for (int k0 = 0; k0 < D; k0 += 64) {
            __syncthreads();
#pragma unroll
            for (int j = 0; j < 4; ++j) { const int f = tid + 512 * j, r = f >> 4, c4 = (f & 15) * 4;
                HT[r * 65 + c4] = ph[j][0]; HT[r * 65 + c4 + 1] = ph[j][1]; HT[r * 65 + c4 + 2] = ph[j][2]; HT[r * 65 + c4 + 3] = ph[j][3];
                WTt[(f & 63) * 32 + (f >> 6)] = pw[j]; }
            __syncthreads();
            if (k0 + 64 < D) RT_LOAD(k0 + 64);
#pragma unroll 8
            for (int s = 0; s < 16; ++s) { const int k = 32 * kh + 2 * s + lk;
                lacc = __builtin_amdgcn_mfma_f32_32x32x2f32(HT[(32 * mg + li) * 65 + k], WTt[k * 32 + li], lacc, 0, 0, 0); }
        }
#undef RT_LOAD
        __syncthreads();
        { LAS float* PART = HT;
          if (kh == 1) {
#pragma unroll
              for (int r = 0; r < 16; ++r) PART[(32 * mg + (r & 3) + 8 * (r >> 2) + 4 * lk) * 33 + li] = lacc[r]; }
          __syncthreads();
          if (kh == 0) {
#pragma unroll
              for (int r = 0; r < 16; ++r) { const int tok = 32 * mg + (r & 3) + 8 * (r >> 2) + 4 * lk; LG[tok * 33 + li] = (lacc[r] + PART[tok * 33 + li]) * RS[tok] + F.in[25][li]; } }
        }
        for (int r = F.wave; r < 128; r += 8) { const int row = tb + r; const u32x2* xr = (const u32x2*)(h2 + (size_t)row * D) + F.lane; f32x4 v[4]; float mx = 0.f;
#pragma unroll
            for (int j = 0; j < 4; ++j) { const u32x2 hw_ = xr[64 * j]; v[j] = (f32x4){bflo(hw_.x), bfhi(hw_.x), bflo(hw_.y), bfhi(hw_.y)}; mx = fmaxf(mx, fmaxf(fmaxf(fabsf(v[j][0]), fabsf(v[j][1])), fmaxf(fabsf(v[j][2]), fabsf(v[j][3])))); }
#pragma unroll
            for (int o = 1; o < 64; o <<= 1) mx = fmaxf(mx, __shfl_xor(mx, o));
            const float qs = mx > 0.f ? 127.0f / mx : 0.f; unsigned* hq = (unsigned*)(F.ws + WS_HQ) + (size_t)row * 256 + F.lane;
#pragma unroll
            for (int j = 0; j < 4; ++j) { unsigned wd = 0;
#pragma unroll
                for (int i = 0; i < 4; ++i) { const int iv = (int)rintf(v[j][i] * qs); wd |= ((unsigned)iv & 0xffu) << (8 * i); }
                hq[64 * j] = wd; }
            if (F.lane == 0) QS[r] = mx * (1.0f / 127.0f); }
        __syncthreads();
        int myidx[4]; float mygate[4];
#pragma unroll
        for (int k = 0; k < 4; ++k) { myidx[k] = 0; mygate[k] = 0.f; }
        if (tid < 128) {
            unsigned sel = 0u; float tv[4];
#pragma unroll
            for (int k = 0; k < 4; ++k) { float best = -3.0e38f; int bi = 0;
                for (int e = 0; e < 32; ++e) { const float lv = LG[tid * 33 + e]; const bool ok = !((sel >> e) & 1u) && lv > best; best = ok ? lv : best; bi = ok ? e : bi; }
                sel |= 1u << bi; myidx[k] = bi; tv[k] = best; }
            const float e0 = 1.0f, e1 = __expf(tv[1] - tv[0]), e2 = __expf(tv[2] - tv[0]), e3 = __expf(tv[3] - tv[0]); const float inv = 1.0f / (e0 + e1 + e2 + e3);
            mygate[0] = e0 * inv; mygate[1] = e1 * inv; mygate[2] = e2 * inv; mygate[3] = e3 * inv;
            SEL[tid] = sel;
        }
        __syncthreads();
        int myrank[4];
#pragma unroll
        for (int k = 0; k < 4; ++k) myrank[k] = 0;
        if (tid < 128) {
            for (int t2 = 0; t2 < tid; ++t2) { const unsigned s = SEL[t2];
#pragma unroll
                for (int k = 0; k < 4; ++k) myrank[k] += (int)((s >> myidx[k]) & 1u); }
        }
#if ROUTER_TICKET
        if (tid == 0) { unsigned sp = 0; while (__hip_atomic_load(F.ctl + CW_TICKET, __ATOMIC_RELAXED, __HIP_MEMORY_SCOPE_AGENT) != (unsigned)blk) { __builtin_amdgcn_s_sleep(2); if (++sp > (1u << 22)) break; } }
        __syncthreads();
#endif
        if (tid >= 128 && tid < 160) { const int e = tid - 128; int cnt = 0; for (int t2 = 0; t2 < 128; ++t2) cnt += (int)((SEL[t2] >> e) & 1u);
            WBASE[e] = cnt > 0 ? (int)__hip_atomic_fetch_add(F.ctl + CW_CNT + 64 * e, (unsigned)cnt, __ATOMIC_RELAXED, __HIP_MEMORY_SCOPE_AGENT) : 0; }
        __syncthreads();
#if ROUTER_TICKET
        if (tid == 0) __hip_atomic_fetch_add(F.ctl + CW_TICKET, 1u, __ATOMIC_RELAXED, __HIP_MEMORY_SCOPE_AGENT);
#endif
        if (tid < 128) { const int tok = tb + tid; const float rs = RS[tid];
#pragma unroll
            for (int k = 0; k < 4; ++k) { const int e = myidx[k], pos = WBASE[e] + myrank[k];
                ltok[(size_t)e * T + pos] = tok; lgate[(size_t)e * T + pos] = mygate[k]; lrstd[(size_t)e * T + pos] = rs * QS[tid];
                pair[(size_t)tok * 8 + 2 * k] = e; pair[(size_t)tok * 8 + 2 * k + 1] = pos; } }
        __syncthreads();
    }
}
__device__ __forceinline__ void moe_tables(Frame& F, int npn) {
    LAS int* tab = (LAS int*)(F.lds + TAB_OFF);
    __syncthreads();
    if (F.tid == 0) { int rs = 0, us = 0;
        for (int e = 0; e < 32; ++e) { const int c = (int)__hip_atomic_load(F.ctl + CW_CNT + 64 * e, __ATOMIC_RELAXED, __HIP_MEMORY_SCOPE_AGENT); tab[e] = rs; tab[64 + e] = us; rs += c; us += ((c + 255) >> 8) * npn; }
        tab[32] = rs; tab[96] = us; }
    __syncthreads();
}
__device__ __forceinline__ void p13_combine(Frame& F) {
    const LAS int* tab = (const LAS int*)(F.lds + TAB_OFF);
    const int gw = F.vcu * 8 + F.wave, NGW = F.G * 8, lane = F.lane;
    const bf16_t* yb = WSP(bf16_t, WS_YB); const int* pair = WSP(int, WS_PAIR);
    for (int m = gw; m < T; m += NGW) {
        f32x4* hr = (f32x4*)(F.out + (size_t)m * D) + lane; const f32x4* gp = (const f32x4*)F.in[30] + lane; const u32x2* hsrc = (const u32x2*)(WSP(bf16_t, WS_H) + (size_t)m * D) + lane;
        f32x4 v[4];
#pragma unroll
        for (int j = 0; j < 4; ++j) { const u32x2 hw_ = hsrc[64 * j]; v[j] = (f32x4){bflo(hw_.x), bfhi(hw_.x), bflo(hw_.y), bfhi(hw_.y)}; }
#pragma unroll
        for (int k = 0; k < 4; ++k) { const int e = pair[(size_t)m * 8 + 2 * k], pos = pair[(size_t)m * 8 + 2 * k + 1]; const size_t row = (size_t)(tab[e] + pos);
            const int* yr = (const int*)((const unsigned char*)yb + row * D) + lane;
#pragma unroll
            for (int j = 0; j < 4; ++j) { const int y = yr[64 * j]; const f32x2 lo = __builtin_amdgcn_cvt_pk_f32_fp8(y, false), hi = __builtin_amdgcn_cvt_pk_f32_fp8(y, true);
                v[j][0] += lo[0]; v[j][1] += lo[1]; v[j][2] += hi[0]; v[j][3] += hi[1]; } }
        float s = 0.f;
#pragma unroll
        for (int j = 0; j < 4; ++j) s += (v[j][0] * v[j][0] + v[j][1] * v[j][1]) + (v[j][2] * v[j][2] + v[j][3] * v[j][3]);
        const float rs = rsqrtf(wave_sum(s) * (1.0f / D) + EPS);
#pragma unroll
        for (int j = 0; j < 4; ++j) { const f32x4 g = gp[64 * j]; hr[64 * j] = v[j] * rs * g; }
    }
}

struct Args { const float* in[31]; float* out; unsigned char* ws; int ph_lo, ph_hi, li, pad; };
__global__ void __launch_bounds__(512, 2) mk_fwd(Args args) {
    extern __shared__ __attribute__((aligned(16))) unsigned char lds_raw[];
    Frame F;
    F.lds = (LAS unsigned char*)lds_raw;
    F.tid = threadIdx.x; F.lane = F.tid & 63; F.wave = __builtin_amdgcn_readfirstlane(F.tid >> 6);
    F.G = gridDim.x; { const int bx = blockIdx.x; F.vcu = (F.G % 8 == 0) ? (bx % 8) * (F.G / 8) + bx / 8 : bx; }
#pragma unroll
    for (int i = 0; i < 31; ++i) F.in[i] = args.in[i];
    F.out = args.out; F.ws = args.ws; F.ctl = (unsigned*)(args.ws + WS_CTL);
    volatile LAS unsigned* MISC = (volatile LAS unsigned*)(F.lds + MISC_OFF);
    if (F.tid < 32) MISC[F.tid] = 0u;
    __syncthreads();
    XcdBarrier bar; bar.bar = F.ctl + CW_BAR; bar.x = 0; bar.st = nullptr;
    if (MK_N_LAUNCHES != NPHASE) bar = xcd_barrier_post(F.ctl + CW_BAR, MISC + 8);
    const int lo = args.ph_lo, hi = args.ph_hi;
#define IN(k) ((lo <= (k) && (k) < hi) && (F.lane = lane_id_(), F.tid = F.wave * 64 + F.lane, true))
#define SEAM(k) do { if (MK_N_LAUNCHES != NPHASE) { if (IN(k) && IN((k) + 1)) xcd_barrier(bar); } } while (0)
    const int bid = (int)blockIdx.x;

    if (IN(0)) _Pragma("unroll") for (int rep_ = 0; rep_ < NREP(0); ++rep_) p0_prologue(F);
    SEAM(0);
    if (IN(1)) _Pragma("unroll") for (int rep_ = 0; rep_ < NREP(1); ++rep_) {
        pg8::DenseSched S; S.init(T, NPROJ, F.G, bid, F.ws + WS_HN, F.ws + WS_WIN, 1024, 1024);
        EpiI8Scale E{WSP(bf16_t, WS_PROJ), NPROJ, WSP(float, WS_RSC), WSP(float, WS_CBIN)};
        pg8::gemm_phase<EpiI8Scale, pg8::DenseSched, false, true>(F.wave, F.lds, 1024, 1024, 512, S, E);
    }
    SEAM(1);
    if (IN(2)) _Pragma("unroll") for (int rep_ = 0; rep_ < NREP(2); ++rep_) p2_conv(F);
    SEAM(2);
    if (IN(3)) _Pragma("unroll") for (int rep_ = 0; rep_ < NREP(3); ++rep_) {
        for (int it = bid; it < 256; it += F.G) { const int x = it & 7, y = it >> 3;
            if (y < 16) { const int gi = x + 8 * (y >> 2), hin = y & 3; p3_ssd_unit(F, gi >> 2, 4 * (gi & 3) + hin); if (REP_SSD) p3_ssd_unit(F, gi >> 2, 4 * (gi & 3) + hin); }
            else { const int idx = x + 8 * (y - 16); p3_lru_unit(F, idx >> 4, idx & 15); if (REP_LRU) p3_lru_unit(F, idx >> 4, idx & 15); } }
    }
    if (IN(3)) {
        const int half = F.G >> 1;
        if (bid >= half) { KvSched S{F.G - half, bid - half, (const char*)(F.ws + WS_MNB), (const char*)(F.ws + WS_WK), (const char*)(F.ws + WS_WK + MiB)};
            EpiKVI8 E{WSP(bf16_t, WS_KM), WSP(bf16_t, WS_VT), WSP(float, WS_MSC), WSP(float, WS_CBKV)};
            pg8::gemm_phase<EpiKVI8, KvSched, false, true>(F.wave, F.lds, 1024, 1024, 512, S, E); }
    }
    SEAM(3);
    if (IN(5)) _Pragma("unroll") for (int rep_ = 0; rep_ < NREP(5); ++rep_) {
        pg8::DenseSched S; S.init(T, D, F.G, bid, WSP(bf16_t, WS_YCAT), WSP(bf16_t, WS_WOUT), 4096, 4096);
        EpiResid<2, false> E{F.in[0], WSP(bf16_t, WS_H), WSP(bf16_t, WS_HB), WSP(float, WS_SS1)};
        GnKHook KH{WSP(float, WS_SSQ)};
        pg8::gemm_phase<EpiResid<2, false>, pg8::DenseSched, false, false, GnKHook>(F.wave, F.lds, 4096, 4096, 2048, S, E, KH);
    }
    SEAM(5);
    if (IN(6)) _Pragma("unroll") for (int rep_ = 0; rep_ < NREP(6); ++rep_) {
        AttnSched S{F.G, bid, 2, (const char*)WSP(bf16_t, WS_HB), (const char*)(F.ws + WS_WQ)};
        EpiRowScaleI8 E{WSP(bf16_t, WS_Q), D, WSP(float, WS_SS1), WSP(float, WS_CBQ), (H1Q_CLIP / 127.0f) * 0.0625f};
        pg8::gemm_phase<EpiRowScaleI8, AttnSched, false, true>(F.wave, F.lds, 1024, 1024, 512, S, E);
    }
    if (MK_N_LAUNCHES == NPHASE) { SEAM(6); } else { VM_WAIT(); __syncthreads(); }
    if (IN(7)) _Pragma("unroll") for (int rep_ = 0; rep_ < NREP(7); ++rep_) {
        AttnSched S{F.G, bid, 0, (const char*)WSP(bf16_t, WS_Q), (const char*)WSP(bf16_t, WS_KM)};
        EpiSoftmax E{WSP(bf16_t, WS_P)};
        pg8::gemm_phase<EpiSoftmax, AttnSched, false>(F.wave, F.lds, 2048, 2048, 256, S, E);
    }
    if (MK_N_LAUNCHES == NPHASE) { SEAM(7); } else { VM_WAIT(); __syncthreads(); }
    if (IN(8)) _Pragma("unroll") for (int rep_ = 0; rep_ < NREP(8); ++rep_) {
        AttnSched S{F.G, bid, 1, (const char*)WSP(bf16_t, WS_P), (const char*)WSP(bf16_t, WS_VT)};
        EpiBf16 E{WSP(bf16_t, WS_Q), D, WSP(bf16_t, WS_Q), D};
        pg8::gemm_phase<EpiBf16, AttnSched, false>(F.wave, F.lds, 2048, 4096, 256, S, E);
    }
    SEAM(8);
    if (IN(9)) {
        pg8::DenseSched S; S.init(T, D, F.G, bid, WSP(bf16_t, WS_Q), WSP(bf16_t, WS_WO), 2048, 2048);
        EpiResid<0, true> E{WSP(bf16_t, WS_H), WSP(bf16_t, WS_H), WSP(bf16_t, WS_HB), WSP(float, WS_SS2)};
        pg8::gemm_phase<EpiResid<0, true>, pg8::DenseSched, false>(F.wave, F.lds, 2048, 2048, 1024, S, E);
    }
    SEAM(9);
    if (IN(10)) p10_router(F);
    SEAM(10);
    if (IN(11)) _Pragma("unroll") for (int rep_ = 0; rep_ < NREP(11); ++rep_) {
        moe_tables(F, 8);
        MoeSched S{F.G, bid, 8, 1, (const LAS int*)(F.lds + TAB_OFF), (const char*)(F.ws + WS_HQ), (const char*)(F.ws + WS_WGU), WSP(int, WS_LTOK), (size_t)2048 * 1024, 1024};
        EpiSwigluI8 E{WSP(bf16_t, WS_ACT), F.in[27], WSP(float, WS_LRSTD), WSP(float, WS_CB)};
        pg8::gemm_phase<EpiSwigluI8, MoeSched, true, true>(F.wave, F.lds, 1024, 1024, 512, S, E);
    }
    SEAM(11);
    if (IN(12)) _Pragma("unroll") for (int rep_ = 0; rep_ < NREP(12); ++rep_) {
        moe_tables(F, 4);
        MoeSched S{F.G, bid, 4, 0, (const LAS int*)(F.lds + TAB_OFF), (const char*)(F.ws + WS_ACT), (const char*)(F.ws + WS_WD), WSP(int, WS_LTOK), (size_t)1024 * 1024, 1024};
        EpiDown E{WSP(bf16_t, WS_YB), F.in[29], WSP(float, WS_LGATE), WSP(float, WS_CBD)};
        pg8::gemm_phase<EpiDown, MoeSched, false, true>(F.wave, F.lds, 1024, 1024, 512, S, E);
    }
    SEAM(12);
    if (MK_N_LAUNCHES != NPHASE) { for (int xb_ = 0; xb_ < EXTRA_BARS; ++xb_) xcd_barrier(bar); }
    if (IN(13)) { moe_tables(F, 4); p13_combine(F); }
#if DBG_DUMP
    if (IN(14)) {
        const bf16_t* src = DBG_DUMP == 1 ? WSP(bf16_t, WS_PROJ) : DBG_DUMP == 2 ? WSP(bf16_t, WS_CV) : DBG_DUMP == 3 ? WSP(bf16_t, WS_YCAT) : DBG_DUMP == 4 ? WSP(bf16_t, WS_Q) : DBG_DUMP == 5 ? WSP(bf16_t, WS_P) : DBG_DUMP == 6 ? WSP(bf16_t, WS_HB) : DBG_DUMP == 7 ? WSP(bf16_t, WS_ACT) : WSP(bf16_t, WS_YB);
        const int ld = DBG_DUMP == 1 ? 5120 : DBG_DUMP == 2 ? 3072 : DBG_DUMP == 3 ? 2048 : 1024;
#if DBG_DUMP == 11
        for (size_t i = (size_t)bid * 512 + F.tid; i < (size_t)T * D; i += (size_t)F.G * 512) { const size_t t = i >> 10; const int c = (int)(i & 15); F.out[i] = WSP(float, WS_DTV)[t * 16 + c] + 3.0f * WSP(float, WS_ACS)[t * 16 + c]; }
        if (0)
#endif
#if DBG_DUMP == 9 || DBG_DUMP == 10
        for (size_t i = (size_t)bid * 512 + F.tid; i < (size_t)T * D; i += (size_t)F.G * 512) { const size_t t = i >> 10; const int c = (int)(i & 1023); F.out[i] = bf2f(WSP(bf16_t, WS_YCAT)[t * 2048 + c + (DBG_DUMP == 9 ? 1024 : 0)]); }
        if (0)
#endif
        for (size_t i = (size_t)bid * 512 + F.tid; i < (size_t)T * D; i += (size_t)F.G * 512) { const size_t t = i >> 10; const int c = (int)(i & 1023); float s = 0.f;
            for (int j = 0; j < ld / 1024; ++j) s += bf2f(src[t * ld + c + 1024 * j]);
            F.out[i] = s; }
    }
#endif
#undef IN
#undef SEAM
}

extern "C" void kernel_launch(void* const* d_in, const int* in_sizes, int n_in, void* d_out, int out_size, void* d_ws, size_t ws_size, hipStream_t stream) {
    static int grid = 0;
    if (grid == 0) {
        if (n_in != 31 || in_sizes[0] != T * D || out_size != T * D || ws_size < WS_END) { fprintf(stderr, "kernel_launch: unexpected problem (n_in %d, in0 %d, out %d, ws %zu < %zu?)\n", n_in, n_in > 0 ? in_sizes[0] : -1, out_size, ws_size, (size_t)WS_END); grid = -1; return; }
        int dev = 0, cus = 0, per_cu = 0;
        if (hipGetDevice(&dev) != hipSuccess || hipDeviceGetAttribute(&cus, hipDeviceAttributeMultiprocessorCount, dev) != hipSuccess) { grid = -1; return; }
        if (hipFuncSetAttribute((const void*)mk_fwd, hipFuncAttributeMaxDynamicSharedMemorySize, LDS_BYTES) != hipSuccess) { fprintf(stderr, "kernel_launch: hipFuncSetAttribute failed\n"); grid = -1; return; }
        if (hipOccupancyMaxActiveBlocksPerMultiprocessor(&per_cu, (const void*)mk_fwd, 512, LDS_BYTES) != hipSuccess || per_cu < 1) fprintf(stderr, "kernel_launch: occupancy query says %d\n", per_cu);
        (void)hipGetLastError();
        grid = cus;
    }
    if (grid < 0) return;
    if (hipMemsetAsync((char*)d_ws + WS_CTL, 0, CTL_ZERO_BYTES, stream) != hipSuccess) return;
    Args a{};
    for (int i = 0; i < 31; ++i) a.in[i] = (const float*)d_in[i];
    a.out = (float*)d_out; a.ws = (unsigned char*)d_ws; a.pad = 0;
    for (int li = 0; li < MK_N_LAUNCHES + (DBG_DUMP ? 1 : 0); ++li) {
        if (li > DBG_STOP && li < NPHASE) continue;
        a.ph_lo = (MK_N_LAUNCHES == NPHASE) ? li : 0; a.ph_hi = (MK_N_LAUNCHES == NPHASE) ? li + 1 : NPHASE; a.li = 0;
        hipLaunchKernelGGL(mk_fwd, dim3(grid), dim3(512), LDS_BYTES, stream, a);
        const hipError_t le = hipPeekAtLastError();
        if (le != hipSuccess) { fprintf(stderr, "kernel_launch: launch %d failed: %s\n", li, hipGetErrorName(le)); break; }
    }
}
```

```cpp
#include <hip/hip_runtime.h>
#include <cstdio>
#include <cstdint>

#ifndef MK_N_LAUNCHES
#define MK_N_LAUNCHES 1
#endif
#ifndef DBG_SSD
#define DBG_SSD 0
#endif
#ifndef REPEAT_MASK
#define REPEAT_MASK 0
#endif
#define NREP(k) (((REPEAT_MASK >> (k)) & 1) ? 2 : 1)
#ifndef REP_SSD
#define REP_SSD 0
#endif
#ifndef REP_LRU
#define REP_LRU 0
#endif
#ifndef REP0
#define REP0 0
#endif
#ifndef EXTRA_BARS
#define EXTRA_BARS 0
#endif
#ifndef DBG_STOP
#define DBG_STOP 13
#endif
#ifndef DBG_DUMP
#define DBG_DUMP 0
#endif
#define LAS __attribute__((address_space(3)))
#define GAS __attribute__((address_space(1)))

typedef unsigned short bf16_t;
typedef short bf16x8 __attribute__((ext_vector_type(8)));
typedef float f32x4 __attribute__((ext_vector_type(4)));
typedef float f32x2 __attribute__((ext_vector_type(2)));
typedef unsigned u32x4 __attribute__((ext_vector_type(4)));
typedef unsigned u32x2 __attribute__((ext_vector_type(2)));

constexpr int T = 32768, D = 1024, NBATCH = 8, SEQ = 4096, NMEM = 256, MT = NBATCH * NMEM;
constexpr int NPROJ = 5120;
constexpr int PC_X = 1024, PC_XR = 3072, PC_GR = 4096;
constexpr int NCV = 3072;
constexpr int NE = 32, NPAIR = T * 4;
constexpr float EPS = 1e-6f;
constexpr int NPHASE = 14;

constexpr size_t MiB = 1u << 20;
constexpr size_t WS_CTL = 0, CTL_ZERO_BYTES = 256 * 1024;
constexpr size_t WS_WIN = 1 * MiB, WS_WOUT = 11 * MiB, WS_WQ = 15 * MiB, WS_WK = 17 * MiB, WS_WV = 19 * MiB, WS_WO = 21 * MiB;
constexpr size_t WS_WR = 23 * MiB, WS_CB = 23 * MiB + 256 * 1024;
constexpr size_t WS_CBIN = 23 * MiB + 512 * 1024, WS_RSC = 23 * MiB + 576 * 1024;
constexpr size_t WS_CBQ = 23 * MiB + 704 * 1024;
constexpr float H1Q_CLIP = 16.0f;
constexpr size_t WS_CBD = 23 * MiB + 768 * 1024;
constexpr float ACTQ_CLIP = 12.0f;
constexpr size_t WS_MSC = 23 * MiB + 900 * 1024, WS_CBKV = 23 * MiB + 912 * 1024;
constexpr size_t WS_WGU = 24 * MiB, WS_WD = 152 * MiB;
constexpr size_t WS_MNB = 216 * MiB, WS_DTV = 220 * MiB, WS_ACS = 222 * MiB, WS_SSQ = 224 * MiB, WS_SS1 = 226 * MiB, WS_SS2 = 228 * MiB;
constexpr size_t WS_KM = 230 * MiB, WS_VT = 234 * MiB, WS_LTOK = 238 * MiB, WS_LGATE = 242 * MiB, WS_LRSTD = 246 * MiB, WS_PAIR = 250 * MiB;
constexpr size_t WS_RC = 252 * MiB;
constexpr size_t WS_RA = 316 * MiB;
constexpr size_t WS_RB = 636 * MiB;
constexpr size_t WS_END = 956 * MiB;
constexpr size_t WS_HN = WS_RC, WS_Q = WS_RC, WS_PROJ = WS_RA, WS_ACT = WS_RA, WS_CV = WS_RB, WS_YCAT = WS_RB + 192 * MiB, WS_HB = WS_RB, WS_P = WS_RB + 64 * MiB, WS_HQ = WS_RB + 64 * MiB  , WS_YB = WS_RB, WS_H = WS_RA + 192 * MiB  ;
constexpr int CW_BAR = 4096;
constexpr int CW_CNT = 32768;
constexpr int CW_TICKET = 40960;
#ifndef ROUTER_TICKET
#define ROUTER_TICKET 0
#endif

constexpr int RING_BYTES = 131072;
constexpr int XCH_OFF = RING_BYTES;
constexpr int TAB_OFF = RING_BYTES + 8192;
constexpr int MISC_OFF = RING_BYTES + 8192 + 512;
constexpr int LDS_BYTES = 147456;

__device__ __forceinline__ unsigned f2bf(float f) { unsigned u = __builtin_bit_cast(unsigned, f); return (u + 0x7fffu + ((u >> 16) & 1u)) >> 16; }
__device__ __forceinline__ float bf2f(unsigned h) { return __builtin_bit_cast(float, h << 16); }
typedef __bf16 bf16x2_t __attribute__((ext_vector_type(2)));
__device__ __forceinline__ unsigned cvt_pk_bf16(float lo, float hi) { const f32x2 v = (f32x2){lo, hi}; const bf16x2_t b = __builtin_convertvector(v, bf16x2_t); return __builtin_bit_cast(unsigned, b); }
__device__ __forceinline__ float bflo(unsigned w) { return __builtin_bit_cast(float, w << 16); }
__device__ __forceinline__ float bfhi(unsigned w) { return __builtin_bit_cast(float, w & 0xffff0000u); }
__device__ __forceinline__ float sigmoidf_(float x) { return __builtin_amdgcn_rcpf(1.0f + __expf(-x)); }
__device__ __forceinline__ float siluf_(float x) { return x * sigmoidf_(x); }
__device__ __forceinline__ float softplusf_(float x) { return x > 20.f ? x : log1pf(__expf(x)); }
__device__ __forceinline__ float gelu_tanhf_(float x) { const float y = 1.5957691216057308f * (x + 0.044715f * x * x * x); return x * __builtin_amdgcn_rcpf(1.0f + __expf(-y)); }
__device__ __forceinline__ float neg_expm1f_(float x) { const float p = x * (1.0f + x * (0.5f + x * (0.16666667f + x * (0.041666668f + x * 0.0083333338f)))); return x > -0.5f ? -p : 1.0f - __expf(x); }
__device__ __forceinline__ float wave_sum(float v) {
#pragma unroll
    for (int o = 1; o < 64; o <<= 1) v += __shfl_xor(v, o);
    return v;
}
__device__ __forceinline__ int lane_id_() { int l = (int)__builtin_amdgcn_mbcnt_hi(~0u, __builtin_amdgcn_mbcnt_lo(~0u, 0u)); asm volatile("" : "+v"(l)); return l; }
#define LDS_WAIT() asm volatile("s_waitcnt lgkmcnt(0)" ::: "memory")
#define VM_WAIT() asm volatile("s_waitcnt vmcnt(0)" ::: "memory")

namespace pg8 {
constexpr int BM = 256, BK = 64, HALF = 128, HTB = HALF * BK * 2, STAGE_BYTES = 8 * HTB;
__host__ __device__ __forceinline__ int lds_byte(int r, int c) { const int st = (r >> 4) * 2 + (c >> 5), rr = r & 15, cc = c & 31, ob = rr * 64 + cc * 2; return st * 1024 + (ob ^ (((ob >> 9) & 1) << 5)); }
__host__ __device__ __forceinline__ void stage_rc(int b, int& R, int& C) { const int st = b / 1024, sb = b % 1024, swz = sb ^ (((sb >> 9) & 1) << 5); R = (st >> 1) * 16 + swz / 64; C = (st & 1) * 32 + (swz % 64) / 2; }
__host__ __device__ __forceinline__ int perm32(int rho) { const int n = rho >> 4, i = rho & 15; return 8 * (i >> 2) + 4 * n + (i & 3); }

struct Unit { int row0, col0, aux, nvalid, lbase; const char* A; const char* B; };

typedef f32x4 Acc[2][2][4][2];
typedef int i32x4 __attribute__((ext_vector_type(4)));
typedef i32x4 AccI[2][2][4][2];
template <bool I8> struct AccSel { typedef f32x4 T; };
template <> struct AccSel<true> { typedef i32x4 T; };

template <class E> constexpr bool epi_side_v = false;
struct NoKHook { static constexpr bool ON = false; __device__ __forceinline__ void prepare(const Unit&, LAS unsigned char*, int) const {} template <class A> __device__ __forceinline__ void at(int, A&, int, int, LAS unsigned char*) const {} };
template <class Epi, class Sched, bool GATHER, bool I8 = false, class KHook = NoKHook>
__device__ __forceinline__ void gemm_phase(const int wid_in, LAS unsigned char* lds, const int lda_b, const int ldb_b, const int K, const Sched& S, const Epi& E, const KHook& KH = KHook()) {
    const int wid = __builtin_amdgcn_readfirstlane(wid_in), lane = lane_id_(), tid = wid * 64 + lane, wr = wid >> 2, wc = wid & 3, fr = lane & 15, fq = lane >> 4;
    const int nt = K / BK;
    int RA[2], CA[2]; unsigned voffB[2];
#pragma unroll
    for (int i = 0; i < 2; ++i) { int R, C; stage_rc(tid * 16 + i * 8192, R, C); const int Rb = (R & ~31) + perm32(R & 31); RA[i] = R; CA[i] = C * 2; voffB[i] = (unsigned)(Rb * ldb_b + C * 2); }
    const size_t kstep = (size_t)(BK * 2);
    const size_t hstepB = (size_t)HALF * ldb_b;
    const unsigned ldsw = (unsigned)wid * 1024u;
    const int aoff = lds_byte(wr * 64 + fr, fq * 8), boff = lds_byte(wc * 32 + fr, fq * 8);
#define PG8_SA(b, h) (((b) * 2 + (h)) * HTB)
#define PG8_SB(b, h) ((4 + (b) * 2 + (h)) * HTB)
#define PG8_STAGE(bufoff, gbase, voff) do { _Pragma("unroll") for (int _i = 0; _i < 2; ++_i) \
        __builtin_amdgcn_global_load_lds((const unsigned*)((const char*)(gbase) + (voff)[_i]), (LAS unsigned*)(lds + (bufoff) + ldsw + _i * 8192), 16, 0, 0); } while (0)
#define PG8_LDA(dst, b, h) do { _Pragma("unroll") for (int m = 0; m < 4; ++m) _Pragma("unroll") for (int k = 0; k < 2; ++k) dst[m][k] = *(const LAS bf16x8*)(lds + PG8_SA(b, h) + aoff + m * 2048 + k * 1024); } while (0)
#define PG8_LDB(dst, b, h) do { _Pragma("unroll") for (int n = 0; n < 2; ++n) _Pragma("unroll") for (int k = 0; k < 2; ++k) dst[n][k] = *(const LAS bf16x8*)(lds + PG8_SB(b, h) + boff + n * 2048 + k * 1024); } while (0)
#define PG8_MMA(ai, bj, At, Bt) do { __builtin_amdgcn_s_setprio(1); _Pragma("unroll") for (int m = 0; m < 4; ++m) _Pragma("unroll") for (int n = 0; n < 2; ++n) _Pragma("unroll") for (int k = 0; k < 2; ++k) { \
        if constexpr (I8) acc[ai][bj][m][n] = __builtin_bit_cast(acc_t, __builtin_amdgcn_mfma_i32_16x16x64_i8(__builtin_bit_cast(i32x4, Bt[n][k]), __builtin_bit_cast(i32x4, At[m][k]), __builtin_bit_cast(i32x4, acc[ai][bj][m][n]), 0, 0, 0)); \
        else acc[ai][bj][m][n] = __builtin_bit_cast(acc_t, __builtin_amdgcn_mfma_f32_16x16x32_bf16(Bt[n][k], At[m][k], __builtin_bit_cast(f32x4, acc[ai][bj][m][n]), 0, 0, 0)); } __builtin_amdgcn_s_setprio(0); } while (0)
#define PG8_WAIT_V(n) asm volatile("s_waitcnt vmcnt(" #n ")" ::: "memory")
#define PG8_WAIT_L(n) asm volatile("s_waitcnt lgkmcnt(" #n ")" ::: "memory")
#define PG8_BAR __builtin_amdgcn_s_barrier()
#define PG8_SCHED __builtin_amdgcn_sched_barrier(0)
#define PG8_ZERO() do { _Pragma("unroll") for (int a = 0; a < 2; ++a) _Pragma("unroll") for (int b = 0; b < 2; ++b) _Pragma("unroll") for (int m = 0; m < 4; ++m) _Pragma("unroll") for (int n = 0; n < 2; ++n) acc[a][b][m][n] = (acc_t){0, 0, 0, 0}; } while (0)
    Unit cur, nxt; int ui = 0;
    if (!S.next(0, cur)) return;
    typedef typename AccSel<I8>::T acc_t; acc_t acc[2][2][4][2]; PG8_ZERO();
    bf16x8 At[4][2], B0[2][2], B1[2][2];
    unsigned cvA[2][2], nvA[2][2];
    int nnT[2][2];
    S.a_offs(cur, RA, CA, lda_b, cvA);
    bool has_next = S.next(1, nxt); Unit nx2;
    if (GATHER) { if (has_next) S.a_offs(nxt, RA, CA, lda_b, nvA); else { nvA[0][0] = cvA[0][0]; nvA[0][1] = cvA[0][1]; nvA[1][0] = cvA[1][0]; nvA[1][1] = cvA[1][1]; } }
    const char* cA = cur.A; const char* cB = cur.B;
    if constexpr (KHook::ON) KH.prepare(cur, lds, tid);
    if constexpr (epi_side_v<Epi>) E.side_issue(cur, lds, wid, lane);
    PG8_STAGE(PG8_SB(0, 0), cB, voffB); PG8_STAGE(PG8_SB(0, 1), cB + hstepB, voffB); PG8_STAGE(PG8_SA(0, 0), cA, cvA[0]); PG8_STAGE(PG8_SA(0, 1), cA, cvA[1]);
    if (wr == 1) PG8_BAR;
    PG8_WAIT_V(2); PG8_BAR;
    PG8_STAGE(PG8_SB(1, 0), cB + kstep, voffB); PG8_STAGE(PG8_SA(1, 0), cA + kstep, cvA[0]); PG8_STAGE(PG8_SB(1, 1), cB + hstepB + kstep, voffB);
    PG8_WAIT_V(6); PG8_BAR;
    for (;;) {
        const char* nA = has_next ? nxt.A : cA; const char* nB = has_next ? nxt.B : cB;
        const bool has_nx2 = has_next && S.next(ui + 2, nx2);
        if (GATHER) { if (has_nx2) S.a_rows(nx2, RA, nnT); }
#pragma unroll 1
        for (int t = 0; t < nt; t += 2) {
            const bool last = (t == nt - 2);
            if constexpr (KHook::ON) KH.at(t, acc, wr, fr, lds);
            const char* a1 = cA + (size_t)(t + 1) * kstep;
            const char* a2 = last ? nA : cA + (size_t)(t + 2) * kstep; const char* b2 = last ? nB : cB + (size_t)(t + 2) * kstep;
            const char* a3 = a2 + kstep; const char* b3 = b2 + kstep;
            unsigned vA2[2][2];
            if (GATHER) { vA2[0][0] = last ? nvA[0][0] : cvA[0][0]; vA2[0][1] = last ? nvA[0][1] : cvA[0][1]; vA2[1][0] = last ? nvA[1][0] : cvA[1][0]; vA2[1][1] = last ? nvA[1][1] : cvA[1][1]; }
            else { vA2[0][0] = cvA[0][0]; vA2[0][1] = cvA[0][1]; vA2[1][0] = cvA[1][0]; vA2[1][1] = cvA[1][1]; }
            PG8_LDB(B0, 0, 0); PG8_LDB(B1, 0, 1); PG8_SCHED; PG8_LDA(At, 0, 0); PG8_STAGE(PG8_SA(1, 1), a1, cvA[1]);
            PG8_WAIT_V(8); PG8_WAIT_L(0); PG8_BAR; PG8_MMA(0, 0, At, B0); PG8_MMA(0, 1, At, B1); PG8_BAR; PG8_SCHED;
            PG8_LDA(At, 0, 1); PG8_STAGE(PG8_SB(0, 0), b2, voffB); PG8_STAGE(PG8_SB(0, 1), b2 + hstepB, voffB); PG8_STAGE(PG8_SA(0, 0), a2, vA2[0]);
            PG8_WAIT_V(8); PG8_WAIT_L(0); PG8_BAR; PG8_MMA(1, 0, At, B0); PG8_MMA(1, 1, At, B1); PG8_BAR; PG8_SCHED;
            PG8_LDB(B0, 1, 0); PG8_LDB(B1, 1, 1); PG8_SCHED; PG8_LDA(At, 1, 0); PG8_STAGE(PG8_SA(0, 1), a2, vA2[1]);
            PG8_WAIT_V(8); PG8_WAIT_L(0); PG8_BAR; PG8_MMA(0, 0, At, B0); PG8_MMA(0, 1, At, B1); PG8_BAR; PG8_SCHED;
            PG8_LDA(At, 1, 1); PG8_STAGE(PG8_SB(1, 0), b3, voffB); PG8_STAGE(PG8_SB(1, 1), b3 + hstepB, voffB); PG8_STAGE(PG8_SA(1, 0), a3, vA2[0]);
            PG8_WAIT_V(8); PG8_WAIT_L(0); PG8_BAR; PG8_MMA(1, 0, At, B0); PG8_MMA(1, 1, At, B1); PG8_BAR; PG8_SCHED;
        }
        if (wr == 0) PG8_BAR;
        if constexpr (GATHER) { auto hook = [&]() { if (has_nx2) {
#pragma unroll
                    for (int h = 0; h < 2; ++h)
#pragma unroll
                        for (int i = 0; i < 2; ++i) asm volatile("" : "+v"(nnT[h][i])); } };
            E(acc, cur, wr, wc, fr, fq, lds + (epi_side_v<Epi> ? ((ui & 1) << 12) : 0), hook); }
        else E(acc, cur, wr, wc, fr, fq, lds + (epi_side_v<Epi> ? ((ui & 1) << 12) : 0));
        if (!has_next) break;
        if constexpr (KHook::ON) KH.prepare(nxt, lds, tid);
        PG8_ZERO();
        cur = nxt; cA = nA; cB = nB; ++ui;
        if constexpr (epi_side_v<Epi>) E.side_issue(cur, lds + ((ui & 1) << 12), wid, lane);
        if (GATHER) { cvA[0][0] = nvA[0][0]; cvA[0][1] = nvA[0][1]; cvA[1][0] = nvA[1][0]; cvA[1][1] = nvA[1][1];
            if (has_nx2) {
#pragma unroll
                for (int h = 0; h < 2; ++h)
#pragma unroll
                    for (int i = 0; i < 2; ++i) nvA[h][i] = (unsigned)nnT[h][i] * (unsigned)lda_b + (unsigned)CA[i]; } }
        if (has_next) { nxt = nx2; } has_next = has_nx2;
        if (wr == 1) PG8_BAR;
    }
    PG8_WAIT_V(0);
    PG8_BAR;
#undef PG8_SA
#undef PG8_SB
#undef PG8_STAGE
#undef PG8_LDA
#undef PG8_LDB
#undef PG8_MMA
#undef PG8_WAIT_V
#undef PG8_WAIT_L
#undef PG8_BAR
#undef PG8_SCHED
#undef PG8_ZERO
}

struct DenseSched {
    int nM, nN, nwg, G, c, lda_b, ldb_b; const char* A; const char* B;
    __device__ __forceinline__ void init(int M, int N, int G_, int c_, const void* A_, const void* B_, int lda_b_, int ldb_b_) { nM = M / BM; nN = N / BM; nwg = nM * nN; G = G_; c = c_; A = (const char*)A_; B = (const char*)B_; lda_b = lda_b_; ldb_b = ldb_b_; }
    __device__ __forceinline__ bool next(int i, Unit& u) const {
        const long L = (long)i * G + c; if (L >= nwg) return false;
        int wgid = (int)L; { const int q = nwg / 8, r = nwg % 8, xcd = wgid % 8, off = wgid / 8; wgid = (xcd < r ? xcd * (q + 1) : r * (q + 1) + (xcd - r) * q) + off; }
        const int nig = 8 * nN, gid = wgid / nig, fm = gid * 8, gsz = (nM - fm) < 8 ? (nM - fm) : 8;
        const int pm = fm + ((wgid % nig) % gsz), pn = (wgid % nig) / gsz;
        u.row0 = pm * BM; u.col0 = pn * BM; u.aux = 0; u.nvalid = BM; u.lbase = 0;
        u.A = A + (size_t)pm * BM * lda_b; u.B = B + (size_t)pn * BM * ldb_b; return true;
    }
    __device__ __forceinline__ void a_rows(const Unit&, const int (&)[2], int (&)[2][2]) const {}
    __device__ __forceinline__ void a_offs(const Unit&, const int (&RA)[2], const int (&CA)[2], int lda_b_, unsigned (&v)[2][2]) const {
#pragma unroll
        for (int h = 0; h < 2; ++h)
#pragma unroll
            for (int i = 0; i < 2; ++i) v[h][i] = (unsigned)((RA[i] + HALF * h) * lda_b_ + CA[i]);
    }
};
}
using pg8::Unit; using pg8::Acc; using pg8::AccI; using pg8::i32x4;

__device__ __forceinline__ unsigned pack_i8x4(float a, float b, float c, float d) {
    unsigned w = 0;
    w = __builtin_amdgcn_cvt_pk_u8_f32(a + 128.0f, 0, w); w = __builtin_amdgcn_cvt_pk_u8_f32(b + 128.0f, 1, w);
    w = __builtin_amdgcn_cvt_pk_u8_f32(c + 128.0f, 2, w); w = __builtin_amdgcn_cvt_pk_u8_f32(d + 128.0f, 3, w);
    return w ^ 0x80808080u;
}
__device__ __forceinline__ unsigned pack_i8x4_biased(float a, float b, float c, float d) {
    unsigned w = 0;
    w = __builtin_amdgcn_cvt_pk_u8_f32(a, 0, w); w = __builtin_amdgcn_cvt_pk_u8_f32(b, 1, w);
    w = __builtin_amdgcn_cvt_pk_u8_f32(c, 2, w); w = __builtin_amdgcn_cvt_pk_u8_f32(d, 3, w);
    return w ^ 0x80808080u;
}
__device__ __forceinline__ u32x4 widen16(u32x2 a, u32x2 b) {
    const auto r0 = __builtin_amdgcn_permlane16_swap(a.x, b.x, false, false);
    const auto r1 = __builtin_amdgcn_permlane16_swap(a.y, b.y, false, false);
    return (u32x4){r0[0], r1[0], r0[1], r1[1]};
}
#define EPI_ROW(ai, m) (128 * (ai) + 64 * wr + 16 * (m) + fr)
#define EPI_COL(bj) (128 * (bj) + 32 * wc + 8 * fq)
__device__ __forceinline__ u32x4 pack8(const f32x4 v0, const f32x4 v1) { u32x4 w; w.x = cvt_pk_bf16(v0[0], v0[1]); w.y = cvt_pk_bf16(v0[2], v0[3]); w.z = cvt_pk_bf16(v1[0], v1[1]); w.w = cvt_pk_bf16(v1[2], v1[3]); return w; }

struct EpiBf16 {
    bf16_t* O0; int ldc0; bf16_t* O1; int ldc1;
    __device__ __forceinline__ void operator()(const Acc& acc, const Unit& u, int wr, int wc, int fr, int fq, LAS unsigned char*) const {
        asm volatile("" : "+v"(fr), "+v"(fq));
        bf16_t* O = u.aux ? O1 : O0; const int ldc = u.aux ? ldc1 : ldc0; const __amdgpu_buffer_rsrc_t ors_ = __builtin_amdgcn_make_buffer_rsrc((void*)(O), 0, 0x7fffffff, 0x00020000);
#pragma unroll
        for (int ai = 0; ai < 2; ++ai)
#pragma unroll
            for (int m = 0; m < 4; ++m) { const unsigned ro = (unsigned)((u.row0 + EPI_ROW(ai, m)) * ldc + u.col0);
#pragma unroll
                for (int bj = 0; bj < 2; ++bj) __builtin_amdgcn_raw_buffer_store_b128(pack8(acc[ai][bj][m][0], acc[ai][bj][m][1]), ors_, (ro + EPI_COL(bj)) * 2u, 0, 16); }
    }
};
struct EpiKVI8 {
    bf16_t* KM; bf16_t* VT; const float* msc; const float* cbkv;
    __device__ __forceinline__ void operator()(const AccI& acc, const Unit& u, int wr, int wc, int fr, int fq, LAS unsigned char*) const {
        asm volatile("" : "+v"(fr), "+v"(fq));
        bf16_t* O = u.aux ? VT : KM; const int ldc = u.aux ? 2048 : 1024; const float* rsc = u.aux ? cbkv + 1024 : msc; const float* csc = u.aux ? msc : cbkv;
        f32x4 cs[2][2];
#pragma unroll
        for (int bj = 0; bj < 2; ++bj)
#pragma unroll
            for (int n = 0; n < 2; ++n) cs[bj][n] = *(const f32x4*)(csc + u.col0 + EPI_COL(bj) + 4 * n);
        float rv[2][4];
#pragma unroll
        for (int ai = 0; ai < 2; ++ai)
#pragma unroll
            for (int m = 0; m < 4; ++m) rv[ai][m] = rsc[u.row0 + EPI_ROW(ai, m)];
#pragma unroll
        for (int ai = 0; ai < 2; ++ai)
#pragma unroll
            for (int m = 0; m < 4; ++m) { bf16_t* rowp = O + (size_t)(u.row0 + EPI_ROW(ai, m)) * ldc + u.col0; const float rs = rv[ai][m];
#pragma unroll
                for (int bj = 0; bj < 2; ++bj) { f32x4 v0, v1;
#pragma unroll
                    for (int i = 0; i < 4; ++i) { v0[i] = (float)acc[ai][bj][m][0][i] * (rs * cs[bj][0][i]); v1[i] = (float)acc[ai][bj][m][1][i] * (rs * cs[bj][1][i]); }
                    *(u32x4*)(rowp + EPI_COL(bj)) = pack8(v0, v1); } }
    }
};
struct EpiI8Scale {
    bf16_t* O; int ldc; const float* rsc; const float* csc;
    __device__ __forceinline__ void side_issue(const Unit& u, LAS unsigned char* lds, int wid, int lane) const {
        asm volatile("" : "+v"(lane));
        const float* src = wid < 4 ? rsc + u.row0 + 64 * wid + lane : csc + u.col0 + 64 * (wid - 4) + lane;
        __builtin_amdgcn_global_load_lds((const unsigned*)src, (LAS unsigned*)(lds + XCH_OFF + 256 * wid), 4, 0, 0); }
    __device__ __forceinline__ void operator()(const AccI& acc, const Unit& u, int wr, int wc, int fr, int fq, LAS unsigned char* lds) const {
        asm volatile("" : "+v"(fr), "+v"(fq));
        const __amdgpu_buffer_rsrc_t rs_ = __builtin_amdgcn_make_buffer_rsrc((void*)O, 0, 0x7fffffff, 0x00020000);
        f32x4 cs[2][2];
#pragma unroll
        for (int bj = 0; bj < 2; ++bj)
#pragma unroll
            for (int n = 0; n < 2; ++n) cs[bj][n] = *(const LAS f32x4*)(lds + XCH_OFF + 1024 + 4 * (EPI_COL(bj) + 4 * n));
        float rv[2][4];
#pragma unroll
        for (int ai = 0; ai < 2; ++ai)
#pragma unroll
            for (int m = 0; m < 4; ++m) rv[ai][m] = *(const LAS float*)(lds + XCH_OFF + 4 * EPI_ROW(ai, m));
#pragma unroll
        for (int ai = 0; ai < 2; ++ai)
#pragma unroll
            for (int m = 0; m < 4; ++m) { const unsigned ro = (unsigned)((u.row0 + EPI_ROW(ai, m)) * ldc + u.col0); const float rs = rv[ai][m];
#pragma unroll
                for (int bj = 0; bj < 2; ++bj) { u32x4 w;
#pragma unroll
                    for (int n = 0; n < 2; ++n)
#pragma unroll
                        for (int ip = 0; ip < 2; ++ip) {
                            const f32x2 a2 = (f32x2){(float)acc[ai][bj][m][n][2 * ip], (float)acc[ai][bj][m][n][2 * ip + 1]};
                            const f32x2 v2 = a2 * ((f32x2){cs[bj][n][2 * ip], cs[bj][n][2 * ip + 1]} * rs);
                            w[2 * n + ip] = cvt_pk_bf16(v2[0], v2[1]); }
                    __builtin_amdgcn_raw_buffer_store_b128(w, rs_, (ro + EPI_COL(bj)) * 2u, 0, 16); } }
    }
};
template <> constexpr bool pg8::epi_side_v<EpiI8Scale> = true;
struct EpiRowScaleI8 {
    bf16_t* O; int ldc; const float* ss; const float* csc; float asc;
    __device__ __forceinline__ void operator()(const AccI& acc, const Unit& u, int wr, int wc, int fr, int fq, LAS unsigned char*) const {
        asm volatile("" : "+v"(fr), "+v"(fq));
        f32x4 cs[2][2];
#pragma unroll
        for (int bj = 0; bj < 2; ++bj)
#pragma unroll
            for (int n = 0; n < 2; ++n) cs[bj][n] = *(const f32x4*)(csc + u.col0 + EPI_COL(bj) + 4 * n) * asc;
#pragma unroll
        for (int ai = 0; ai < 2; ++ai) {
            f32x4 sp[4][4];
#pragma unroll
            for (int m = 0; m < 4; ++m) { const f32x4* p = (const f32x4*)(ss + (size_t)(u.row0 + EPI_ROW(ai, m)) * 16);
#pragma unroll
                for (int q = 0; q < 4; ++q) sp[m][q] = p[q]; }
#pragma unroll
            for (int m = 0; m < 4; ++m) { const int row = u.row0 + EPI_ROW(ai, m);
                const f32x4 s0 = sp[m][0], s1 = sp[m][1], s2 = sp[m][2], s3 = sp[m][3];
                const float tot = ((s0[0] + s0[1]) + (s0[2] + s0[3])) + ((s1[0] + s1[1]) + (s1[2] + s1[3])) + ((s2[0] + s2[1]) + (s2[2] + s2[3])) + ((s3[0] + s3[1]) + (s3[2] + s3[3]));
                const float rs = rsqrtf(tot * (1.0f / D) + EPS);
                bf16_t* rowp = O + (size_t)row * ldc + u.col0;
#pragma unroll
                for (int bj = 0; bj < 2; ++bj) { f32x4 v0, v1;
#pragma unroll
                    for (int i = 0; i < 4; ++i) { v0[i] = (float)acc[ai][bj][m][0][i] * (rs * cs[bj][0][i]); v1[i] = (float)acc[ai][bj][m][1][i] * (rs * cs[bj][1][i]); }
                    *(u32x4*)(rowp + EPI_COL(bj)) = pack8(v0, v1); } }
        }
    }
};
struct EpiRowScale {
    bf16_t* O; int ldc; const float* ss;
    __device__ __forceinline__ void operator()(const Acc& acc, const Unit& u, int wr, int wc, int fr, int fq, LAS unsigned char*) const {
        asm volatile("" : "+v"(fr), "+v"(fq));
#pragma unroll
        for (int ai = 0; ai < 2; ++ai) {
            f32x4 sp[4][4];
#pragma unroll
            for (int m = 0; m < 4; ++m) { const f32x4* p = (const f32x4*)(ss + (size_t)(u.row0 + EPI_ROW(ai, m)) * 16);
#pragma unroll
                for (int q = 0; q < 4; ++q) sp[m][q] = p[q]; }
#pragma unroll
            for (int m = 0; m < 4; ++m) { const int row = u.row0 + EPI_ROW(ai, m);
                const f32x4 s0 = sp[m][0], s1 = sp[m][1], s2 = sp[m][2], s3 = sp[m][3];
                const float tot = ((s0[0] + s0[1]) + (s0[2] + s0[3])) + ((s1[0] + s1[1]) + (s1[2] + s1[3])) + ((s2[0] + s2[1]) + (s2[2] + s2[3])) + ((s3[0] + s3[1]) + (s3[2] + s3[3]));
                const float rs = rsqrtf(tot * (1.0f / D) + EPS);
                bf16_t* rowp = O + (size_t)row * ldc + u.col0;
#pragma unroll
                for (int bj = 0; bj < 2; ++bj) *(u32x4*)(rowp + EPI_COL(bj)) = pack8(acc[ai][bj][m][0] * rs, acc[ai][bj][m][1] * rs); }
        }
    }
};
template <int WB, bool BASE_BF16> struct EpiResid {
    const void* base; bf16_t* hb; bf16_t* ob; float* ss;
    __device__ __forceinline__ void operator()(const Acc& acc, const Unit& u, int wr, int wc, int fr, int fq, LAS unsigned char*) const {
        const __amdgpu_buffer_rsrc_t hrs_ = __builtin_amdgcn_make_buffer_rsrc((void*)(hb), 0, 0x7fffffff, 0x00020000);
        asm volatile("" : "+v"(fr), "+v"(fq));
#pragma unroll
        for (int ai = 0; ai < 2; ++ai) {
            u32x4 braw[4][2]; f32x4 bf[4][2][2];
#pragma unroll
            for (int m = 0; m < 4; ++m) { const size_t off = (size_t)(u.row0 + EPI_ROW(ai, m)) * D + u.col0;
#pragma unroll
                for (int bj = 0; bj < 2; ++bj) { const int c = EPI_COL(bj);
                    if (BASE_BF16) braw[m][bj] = *(const u32x4*)((const bf16_t*)base + off + c);
                    else { bf[m][bj][0] = *(const f32x4*)((const float*)base + off + c); bf[m][bj][1] = *(const f32x4*)((const float*)base + off + c + 4); } } }
#pragma unroll
            for (int m = 0; m < 4; ++m) { const int row = u.row0 + EPI_ROW(ai, m); const size_t off = (size_t)row * D + u.col0; float q = 0.f;
#pragma unroll
                for (int bj = 0; bj < 2; ++bj) { const int c = EPI_COL(bj);
                    f32x4 b0, b1;
                    if (BASE_BF16) { const u32x4 r = braw[m][bj]; b0 = (f32x4){bflo(r.x), bfhi(r.x), bflo(r.y), bfhi(r.y)}; b1 = (f32x4){bflo(r.z), bfhi(r.z), bflo(r.w), bfhi(r.w)}; }
                    else { b0 = bf[m][bj][0]; b1 = bf[m][bj][1]; }
                    const f32x4 v0 = b0 + acc[ai][bj][m][0], v1 = b1 + acc[ai][bj][m][1];
                    __builtin_amdgcn_raw_buffer_store_b128(pack8(v0, v1), hrs_, (unsigned)((off + c) * 2), 0, 16);
                    if (WB == 2) { u32x2 o; constexpr float QS = 127.0f / H1Q_CLIP;
                        o.x = pack_i8x4(v0[0] * QS, v0[1] * QS, v0[2] * QS, v0[3] * QS); o.y = pack_i8x4(v1[0] * QS, v1[1] * QS, v1[2] * QS, v1[3] * QS);
                        *(u32x2*)((unsigned char*)ob + off + c) = o; }
                    q += (v0[0] * v0[0] + v0[1] * v0[1]) + (v0[2] * v0[2] + v0[3] * v0[3]) + (v1[0] * v1[0] + v1[1] * v1[1]) + (v1[2] * v1[2] + v1[3] * v1[3]); }
                q += __shfl_xor(q, 16); q += __shfl_xor(q, 32);
                if (fq == 0) ss[(size_t)row * 16 + (u.col0 >> 8) * 4 + wc] = q; }
        }
    }
};
struct EpiSoftmax {
    bf16_t* P;
    __device__ __forceinline__ void operator()(Acc& acc, const Unit& u, int wr, int wc, int fr, int fq, LAS unsigned char* lds) const {
        asm volatile("" : "+v"(fr), "+v"(fq));
        LAS f32x2* X = (LAS f32x2*)(lds + XCH_OFF);
        float mloc[2][4];
#pragma unroll
        for (int ai = 0; ai < 2; ++ai)
#pragma unroll
            for (int m = 0; m < 4; ++m) { float mx = -3.0e38f;
#pragma unroll
                for (int bj = 0; bj < 2; ++bj)
#pragma unroll
                    for (int n = 0; n < 2; ++n) { const f32x4 x = acc[ai][bj][m][n]; mx = fmaxf(mx, fmaxf(fmaxf(x[0], x[1]), fmaxf(x[2], x[3]))); }
                mx = fmaxf(mx, __shfl_xor(mx, 16)); mx = fmaxf(mx, __shfl_xor(mx, 32)); float s = 0.f;
#pragma unroll
                for (int bj = 0; bj < 2; ++bj)
#pragma unroll
                    for (int n = 0; n < 2; ++n) { f32x4 x = acc[ai][bj][m][n]; x[0] = __expf(x[0] - mx); x[1] = __expf(x[1] - mx); x[2] = __expf(x[2] - mx); x[3] = __expf(x[3] - mx); acc[ai][bj][m][n] = x; s += (x[0] + x[1]) + (x[2] + x[3]); }
                s += __shfl_xor(s, 16); s += __shfl_xor(s, 32);
                mloc[ai][m] = mx;
                if (fq == 0) X[EPI_ROW(ai, m) * 4 + wc] = (f32x2){mx, s}; }
        LDS_WAIT(); __builtin_amdgcn_s_barrier(); asm volatile("" ::: "memory");
#pragma unroll
        for (int ai = 0; ai < 2; ++ai)
#pragma unroll
            for (int m = 0; m < 4; ++m) { const int lr = EPI_ROW(ai, m);
                const f32x2 a = X[lr * 4 + 0], b = X[lr * 4 + 1], c = X[lr * 4 + 2], d = X[lr * 4 + 3];
                const float M = fmaxf(fmaxf(a.x, b.x), fmaxf(c.x, d.x));
                const float tot = a.y * __expf(a.x - M) + b.y * __expf(b.x - M) + c.y * __expf(c.x - M) + d.y * __expf(d.x - M);
                const float f = __expf(mloc[ai][m] - M) / tot;
                bf16_t* rowp = P + (size_t)(u.row0 + lr) * D + u.col0;
#pragma unroll
                for (int bj = 0; bj < 2; ++bj) *(u32x4*)(rowp + EPI_COL(bj)) = pack8(acc[ai][bj][m][0] * f, acc[ai][bj][m][1] * f); }
    }
};
struct EpiSwiglu {
    bf16_t* act; const float* bgu; const float* lrstd;
    __device__ __forceinline__ void operator()(const Acc& acc, const Unit& u, int wr, int wc, int fr, int fq, LAS unsigned char*) const {
        asm volatile("" : "+v"(fr), "+v"(fq));
        const int j0 = (u.col0 >> 1) + 32 * wc + 8 * fq;
        const float* bp = bgu + (size_t)u.aux * 2048 + 2 * j0;
        f32x4 bb[4];
#pragma unroll
        for (int i = 0; i < 4; ++i) bb[i] = *(const f32x4*)(bp + 4 * i);
        float rsv[2][4];
#pragma unroll
        for (int ai = 0; ai < 2; ++ai)
#pragma unroll
            for (int m = 0; m < 4; ++m) { const int lr = EPI_ROW(ai, m); rsv[ai][m] = lr < u.nvalid ? lrstd[u.lbase + lr] : 0.f; }
#pragma unroll
        for (int ai = 0; ai < 2; ++ai)
#pragma unroll
            for (int m = 0; m < 4; ++m) { const int lr = EPI_ROW(ai, m);
                if (lr < u.nvalid) { const float rs = rsv[ai][m]; f32x4 o[2];
#pragma unroll
                    for (int n = 0; n < 2; ++n)
#pragma unroll
                        for (int i = 0; i < 4; ++i) { const int jj = 4 * n + i;
                            float g = acc[ai][0][m][n][i] * rs + bb[jj >> 1][(jj & 1) * 2];
                            float up = acc[ai][1][m][n][i] * rs + bb[jj >> 1][(jj & 1) * 2 + 1];
                            g = fminf(g, 7.0f); up = fminf(fmaxf(up, -7.0f), 7.0f);
                            o[n][i] = (up + 1.0f) * (g * sigmoidf_(1.702f * g)); }
                    *(u32x4*)(act + (size_t)(u.row0 + lr) * D + j0) = pack8(o[0], o[1]); } }
    }
};
struct EpiSwigluI8 {
    bf16_t* act; const float* bgu; const float* lrs; const float* cb;
    __device__ __forceinline__ void side_issue(const Unit& u, LAS unsigned char* lds, int wid, int lane) const {
        asm volatile("" : "+v"(lane));
        const float* src = wid < 4 ? lrs + u.lbase + 64 * wid + lane : bgu + (size_t)u.aux * 2048 + u.col0 + 64 * (wid - 4) + lane;
        __builtin_amdgcn_global_load_lds((const unsigned*)src, (LAS unsigned*)(lds + XCH_OFF + 256 * wid), 4, 0, 0); }
    template <class Hook>
    __device__ __forceinline__ void operator()(const AccI& acc, const Unit& u, int wr, int wc, int fr, int fq, LAS unsigned char* lds, const Hook& hook) const {
        asm volatile("" : "+v"(fr), "+v"(fq));
        constexpr float QS = 127.0f / ACTQ_CLIP;
        const int j0 = (u.col0 >> 1) + 32 * wc + 8 * fq;
        const __amdgpu_buffer_rsrc_t arsrc = __builtin_amdgcn_make_buffer_rsrc((void*)act, 0, 0x08000000, 0x00020000);
        const LAS float* sd = (const LAS float*)(lds + XCH_OFF);
        const float sc = cb[(size_t)u.aux * 2048 + u.col0 + 32 * wc + 8 * fq];
        float rsv[2][4];
#pragma unroll
        for (int ai = 0; ai < 2; ++ai)
#pragma unroll
            for (int m = 0; m < 4; ++m) { const int lr = EPI_ROW(ai, m); const float t_ = sd[lr]; rsv[ai][m] = lr < u.nvalid ? t_ : 0.f; }
        f32x4 bb[2][2];
#pragma unroll
        for (int n = 0; n < 2; ++n) { bb[n][0] = *(const LAS f32x4*)(sd + 256 + 64 * wc + 16 * fq + 8 * n); bb[n][1] = *(const LAS f32x4*)(sd + 256 + 64 * wc + 16 * fq + 8 * n + 4); }
        hook();
        constexpr float C1 = -1.702f * 1.4426950408889634f, KU = QS / C1;
        f32x2 bg[2][2], bu[2][2];
#pragma unroll
        for (int n = 0; n < 2; ++n)
#pragma unroll
            for (int ip = 0; ip < 2; ++ip) { bg[n][ip] = (f32x2){bb[n][ip][0] * C1, bb[n][ip][2] * C1}; bu[n][ip] = (f32x2){(bb[n][ip][1] + 1.0f) * KU, (bb[n][ip][3] + 1.0f) * KU}; }
#pragma unroll
        for (int ai = 0; ai < 2; ++ai)
#pragma unroll
            for (int mp = 0; mp < 2; ++mp) { u32x2 pk2[2];
#pragma unroll
                for (int mh = 0; mh < 2; ++mh) { const int m = 2 * mp + mh; const float rss = rsv[ai][m] * sc * KU, rsq = rsv[ai][m] * sc * C1; u32x2 pk;
#pragma unroll
                    for (int n = 0; n < 2; ++n) { f32x2 o[2];
#pragma unroll
                        for (int ip = 0; ip < 2; ++ip) {
                            f32x2 gq = (f32x2){(float)acc[ai][0][m][n][2 * ip], (float)acc[ai][0][m][n][2 * ip + 1]} * rsq + bg[n][ip];
                            f32x2 u1 = (f32x2){(float)acc[ai][1][m][n][2 * ip], (float)acc[ai][1][m][n][2 * ip + 1]} * rss + bu[n][ip];
                            gq[0] = fmaxf(gq[0], 7.0f * C1); gq[1] = fmaxf(gq[1], 7.0f * C1);
                            u1[0] = fminf(fmaxf(u1[0], 8.0f * KU), -6.0f * KU); u1[1] = fminf(fmaxf(u1[1], 8.0f * KU), -6.0f * KU);
                            f32x2 e;
                            e[0] = __builtin_amdgcn_exp2f(gq[0]); e[1] = __builtin_amdgcn_exp2f(gq[1]);
                            e = e + 1.0f;
                            const f32x2 r = (f32x2){__builtin_amdgcn_rcpf(e[0]), __builtin_amdgcn_rcpf(e[1])};
                            o[ip] = (u1 * gq) * r + 128.0f; }
                        const unsigned w = pack_i8x4_biased(o[0][0], o[0][1], o[1][0], o[1][1]); if (n == 0) pk.x = w; else pk.y = w; }
                    pk2[mh] = pk; }
                const u32x4 w16 = widen16(pk2[0], pk2[1]);
                const int lrw = EPI_ROW(ai, 2 * mp + (fq & 1));
                if (lrw < u.nvalid) __builtin_amdgcn_raw_buffer_store_b128(w16, arsrc, (unsigned)((u.row0 + lrw) * D + (u.col0 >> 1) + 32 * wc + 16 * (fq >> 1)), 0, 16); }
    }
};
template <> constexpr bool pg8::epi_side_v<EpiSwigluI8> = true;
struct EpiDown {
    bf16_t* yb; const float* bd; const float* lgate; const float* cbd;
    __device__ __forceinline__ void operator()(const AccI& acc, const Unit& u, int wr, int wc, int fr, int fq, LAS unsigned char*) const {
        asm volatile("" : "+v"(fr), "+v"(fq));
        f32x4 bv[2][2], cs[2][2];
#pragma unroll
        for (int bj = 0; bj < 2; ++bj)
#pragma unroll
            for (int n = 0; n < 2; ++n) { bv[bj][n] = *(const f32x4*)(bd + (size_t)u.aux * D + u.col0 + EPI_COL(bj) + 4 * n); cs[bj][n] = *(const f32x4*)(cbd + (size_t)u.aux * D + u.col0 + EPI_COL(bj) + 4 * n) * (ACTQ_CLIP / 127.0f); }
        float gtv[2][4];
#pragma unroll
        for (int ai = 0; ai < 2; ++ai)
#pragma unroll
            for (int m = 0; m < 4; ++m) { const int lr = EPI_ROW(ai, m); gtv[ai][m] = lr < u.nvalid ? lgate[u.lbase + lr] : 0.f; }
#pragma unroll
        for (int ai = 0; ai < 2; ++ai)
#pragma unroll
            for (int mp = 0; mp < 2; ++mp) {
                const int lrw = EPI_ROW(ai, 2 * mp + (fq & 1)); unsigned char* rowp = (unsigned char*)yb + (size_t)(u.row0 + lrw) * D + u.col0;
#pragma unroll
                for (int bj = 0; bj < 2; ++bj) { u32x2 o2[2];
#pragma unroll
                    for (int mh = 0; mh < 2; ++mh) { const int m = 2 * mp + mh; const float gt = gtv[ai][m]; f32x4 y0, y1;
#pragma unroll
                        for (int ip = 0; ip < 2; ++ip) {
                            const f32x2 a0 = (f32x2){(float)acc[ai][bj][m][0][2 * ip], (float)acc[ai][bj][m][0][2 * ip + 1]}, a1 = (f32x2){(float)acc[ai][bj][m][1][2 * ip], (float)acc[ai][bj][m][1][2 * ip + 1]};
                            const f32x2 r0 = (a0 * (f32x2){cs[bj][0][2 * ip], cs[bj][0][2 * ip + 1]} + (f32x2){bv[bj][0][2 * ip], bv[bj][0][2 * ip + 1]}) * gt;
                            const f32x2 r1 = (a1 * (f32x2){cs[bj][1][2 * ip], cs[bj][1][2 * ip + 1]} + (f32x2){bv[bj][1][2 * ip], bv[bj][1][2 * ip + 1]}) * gt;
                            y0[2 * ip] = r0[0]; y0[2 * ip + 1] = r0[1]; y1[2 * ip] = r1[0]; y1[2 * ip + 1] = r1[1]; }
                        int w0 = __builtin_amdgcn_cvt_pk_fp8_f32(y0[0], y0[1], 0, false); w0 = __builtin_amdgcn_cvt_pk_fp8_f32(y0[2], y0[3], w0, true);
                        int w1 = __builtin_amdgcn_cvt_pk_fp8_f32(y1[0], y1[1], 0, false); w1 = __builtin_amdgcn_cvt_pk_fp8_f32(y1[2], y1[3], w1, true);
                        o2[mh].x = (unsigned)w0; o2[mh].y = (unsigned)w1; }
                    const u32x4 w16 = widen16(o2[0], o2[1]);
                    if (lrw < u.nvalid) *(u32x4*)(rowp + 128 * bj + 32 * wc + 16 * (fq >> 1)) = w16; } }
    }
};

struct GnKHook {
    static constexpr bool ON = true;
    const float* ssq;
    __device__ __forceinline__ void prepare(const Unit& u, LAS unsigned char* lds, int tid) const {
        if (tid < 256) { const f32x4* sp = (const f32x4*)(ssq + (size_t)(u.row0 + tid) * 16); float s[4];
#pragma unroll
            for (int g = 0; g < 4; ++g) { const f32x4 q = sp[g]; s[g] = rsqrtf(((q[0] + q[1]) + (q[2] + q[3])) * (1.0f / 256.0f) + EPS); }
            *(LAS f32x4*)(lds + XCH_OFF + tid * 16) = (f32x4){s[0] / s[1], s[1] / s[2], s[2] / s[3], s[3]}; }
    }
    template <class A> __device__ __forceinline__ void at(int t, A& acc, int wr, int fr, LAS unsigned char* lds) const {
        if (t == 4 || t == 8 || t == 12 || t == 16) { const int g = (t >> 2) - 1;
#pragma unroll
            for (int ai = 0; ai < 2; ++ai)
#pragma unroll
                for (int m = 0; m < 4; ++m) { const float r = ((const LAS float*)(lds + XCH_OFF))[(128 * ai + 64 * wr + 16 * m + fr) * 4 + g];
#pragma unroll
                    for (int bj = 0; bj < 2; ++bj)
#pragma unroll
                        for (int n = 0; n < 2; ++n) acc[ai][bj][m][n] = acc[ai][bj][m][n] * r; } }
    }
};
struct KvSched {
    int G, c; const char* MNB; const char* WK; const char* WV;
    __device__ __forceinline__ bool next(int i, Unit& u) const {
        const int L = i * G + c; if (L >= 64) return false;
        u.nvalid = 256; u.lbase = 0;
        if (L < 32) { const int pm = L >> 2, pn = L & 3; u.aux = 0; u.row0 = 256 * pm; u.col0 = 256 * pn; u.A = MNB + (size_t)pm * 256 * 1024; u.B = WK + (size_t)pn * 256 * 1024; }
        else { const int l2 = L - 32, pm = l2 >> 3, pn = l2 & 7; u.aux = 1; u.row0 = 256 * pm; u.col0 = 256 * pn; u.A = WV + (size_t)pm * 256 * 1024; u.B = MNB + (size_t)pn * 256 * 1024; }
        return true;
    }
    __device__ __forceinline__ void a_rows(const Unit&, const int (&)[2], int (&)[2][2]) const {}
    __device__ __forceinline__ void a_offs(const Unit&, const int (&RA)[2], const int (&CA)[2], int lda_b_, unsigned (&v)[2][2]) const {
#pragma unroll
        for (int h = 0; h < 2; ++h)
#pragma unroll
            for (int i = 0; i < 2; ++i) v[h][i] = (unsigned)((RA[i] + 128 * h) * lda_b_ + CA[i]);
    }
};
struct AttnSched {
    int G, c, mode; const char* A; const char* B;
    __device__ __forceinline__ bool next(int i, Unit& u) const {
        const int L = i * G + c; if (L >= 512) return false;
        const int b = L >> 6, h = (L >> 4) & 3, qt = L & 15;
        u.aux = 0; u.nvalid = 256; u.lbase = 0; u.row0 = b * SEQ + 256 * qt; u.col0 = 256 * h;
        if (mode == 2) { u.A = A + (size_t)u.row0 * D; u.B = B + (size_t)(256 * h) * D; return true; }
        u.A = A + ((size_t)u.row0 * D + 256 * h) * 2;
        u.B = mode == 0 ? B + ((size_t)(b * NMEM) * D + 256 * h) * 2 : B + ((size_t)(256 * h) * MT + b * NMEM) * 2;
        return true;
    }
    __device__ __forceinline__ void a_rows(const Unit&, const int (&)[2], int (&)[2][2]) const {}
    __device__ __forceinline__ void a_offs(const Unit&, const int (&RA)[2], const int (&CA)[2], int lda_b_, unsigned (&v)[2][2]) const {
#pragma unroll
        for (int h = 0; h < 2; ++h)
#pragma unroll
            for (int i = 0; i < 2; ++i) v[h][i] = (unsigned)((RA[i] + 128 * h) * lda_b_ + CA[i]);
    }
};
struct MoeSched {
    int G, c, npn, gather; const LAS int* tab; const char* A; const char* W; const int* ltok; size_t wstride; int ldb;
    __device__ __forceinline__ bool next(int i, Unit& u) const {
        const int total = tab[64 + 32]; int L;
        if ((G & 7) == 0) { const int per = (total + 7) >> 3, x = c & 7, lo = x * per, hi = (lo + per < total) ? lo + per : total; L = lo + (c >> 3) + (G >> 3) * i; if (L >= hi) return false; }
        else { L = i * G + c; if (L >= total) return false; }
        const int ln_ = lane_id_(); const int tv_ = tab[64 + (ln_ & 31)];
        const int e = __builtin_amdgcn_readfirstlane((int)__popcll(__ballot(ln_ >= 1 && ln_ < 32 && L >= tv_)));
        const int ub = tab[64 + e], cnt = tab[e + 1] - tab[e], tiles = (cnt + 255) >> 8, idx = L - ub, rt = idx / npn, pn = idx - rt * npn; (void)tiles;
        u.aux = e; u.row0 = tab[e] + 256 * rt; u.col0 = 256 * pn; u.nvalid = cnt - 256 * rt; u.lbase = e * T + 256 * rt;
        u.A = gather ? A : A + (size_t)u.row0 * 1024;
        u.B = W + (size_t)e * wstride + (size_t)pn * 256 * ldb;
        return true;
    }
    __device__ __forceinline__ void a_rows(const Unit& u, const int (&RA)[2], int (&t)[2][2]) const {
#pragma unroll
        for (int h = 0; h < 2; ++h)
#pragma unroll
            for (int i = 0; i < 2; ++i) { const int lr = RA[i] + 128 * h; t[h][i] = lr < u.nvalid ? ltok[u.lbase + lr] : 0; }
    }
    __device__ __forceinline__ void a_offs(const Unit& u, const int (&RA)[2], const int (&CA)[2], int lda_b_, unsigned (&v)[2][2]) const {
#pragma unroll
        for (int h = 0; h < 2; ++h)
#pragma unroll
            for (int i = 0; i < 2; ++i) { const int lr = RA[i] + 128 * h;
                if (gather) { int tok = lr < u.nvalid ? ltok[u.lbase + lr] : 0; asm volatile("" : "+v"(tok)); v[h][i] = (unsigned)tok * (unsigned)lda_b_ + (unsigned)CA[i]; }
                else v[h][i] = (unsigned)(lr * lda_b_ + CA[i]); }
    }
};

#define XB_TMO      128
#define XB_XCNT(j)  (256  + 64 * (j))
#define XB_XSUB(j)  (1280 + 64 * (j))
#define XB_XGEN(j)  (2304 + 64 * (j))
#define XB_TOP      3328
#define XB_TOPGEN   3392
#define XCD_BAR_WORDS 3456
#define XB_SPIN_CAP (1u << 18)
__device__ __forceinline__ unsigned xb_ld(unsigned* p)              { return __hip_atomic_load(p, __ATOMIC_RELAXED, __HIP_MEMORY_SCOPE_AGENT); }
__device__ __forceinline__ unsigned xb_add(unsigned* p, unsigned v) { return __hip_atomic_fetch_add(p, v, __ATOMIC_RELAXED, __HIP_MEMORY_SCOPE_AGENT); }
__device__ __forceinline__ unsigned xb_xcc_id() { return (unsigned)__builtin_amdgcn_s_getreg((3 << 11) | 20) & 0xFu; }
#define XB_SPIN(cond, bar) do { unsigned _sp = 0; while (cond) { __builtin_amdgcn_s_sleep(1); \
    if ((++_sp & 255u) == 0u) { if (xb_ld(&(bar)[XB_TMO])) break; if (_sp > XB_SPIN_CAP) { atomicAdd(&(bar)[XB_TMO], 1u); break; } } } } while (0)
struct XcdBarrier { unsigned* bar; unsigned x; volatile LAS unsigned* st; };
__device__ __forceinline__ XcdBarrier xcd_barrier_post(unsigned* bar, volatile LAS unsigned* st) {
    XcdBarrier b; b.bar = bar; b.x = xb_xcc_id(); b.st = st;
    if (threadIdx.x == 0) (void)xb_add(&bar[XB_XCNT(b.x)], 1u);
    return b;
}
__device__ __forceinline__ void xcd_barrier_complete(unsigned* bar, unsigned x, unsigned& nloc, unsigned& nx) {
    const unsigned G = gridDim.x * gridDim.y * gridDim.z;
    unsigned sum, cnt, mine, sp = 0u;
    for (;;) {
        sum = 0u; cnt = 0u; mine = 0u;
#pragma unroll
        for (unsigned j = 0; j < 16; ++j) { const unsigned c = xb_ld(&bar[XB_XCNT(j)]); sum += c; cnt += (c > 0u) ? 1u : 0u; mine = (j == x) ? c : mine; }
        if (sum == G) break;
        __builtin_amdgcn_s_sleep(1);
        if ((++sp & 255u) == 0u) { if (xb_ld(&bar[XB_TMO])) break; if (sp > XB_SPIN_CAP) { atomicAdd(&bar[XB_TMO], 1u); break; } }
    }
    nloc = mine > 0u ? mine : 1u; nx = cnt > 0u ? cnt : 1u;
}
__device__ __forceinline__ void xcd_barrier(const XcdBarrier& b) {
    asm volatile("s_waitcnt vmcnt(0)" ::: "memory");
    __syncthreads();
    if (threadIdx.x == 0) {
        unsigned* bar = b.bar;
        __builtin_amdgcn_s_waitcnt(0);
        unsigned nloc = b.st[0], nx = b.st[1];
        if (nloc == 0u) { xcd_barrier_complete(bar, b.x, nloc, nx); b.st[0] = nloc; b.st[1] = nx; }
        const unsigned old = xb_add(&bar[XB_XSUB(b.x)], 1u);
        const unsigned gen = old / nloc;
        if (old + 1u == (gen + 1u) * nloc) {
            __builtin_amdgcn_fence(__ATOMIC_RELEASE, "agent");
            asm volatile("s_waitcnt vmcnt(0)" ::: "memory");
            const unsigned og = xb_add(&bar[XB_TOP], 1u);
            const unsigned tg = og / nx;
            if (og + 1u == (tg + 1u) * nx) xb_add(&bar[XB_TOPGEN], 1u);
            else XB_SPIN(xb_ld(&bar[XB_TOPGEN]) == tg, bar);
            __builtin_amdgcn_fence(__ATOMIC_ACQUIRE, "agent");
            xb_add(&bar[XB_XGEN(b.x)], 1u);
            asm volatile("s_waitcnt vmcnt(0)" ::: "memory");
        } else {
            XB_SPIN(xb_ld(&bar[XB_XGEN(b.x)]) == gen, bar);
            __builtin_amdgcn_fence(__ATOMIC_ACQUIRE, "agent");
            asm volatile("s_waitcnt vmcnt(0)" ::: "memory");
        }
    }
    __syncthreads();
}

struct Frame {
    LAS unsigned char* lds;
    unsigned* ctl;
    int tid, lane, wave, vcu, G;
    const float* in[31];
    float* out;
    unsigned char* ws;
};
#define WSP(type, off) ((type*)(F.ws + (off)))

template <class RowMap>
__device__ __forceinline__ void p0_tr_item(const float* W, int N, int k0, int n0, const float* kgain, float sc, bf16_t* dst, int Kdst, RowMap rm, LAS unsigned char* scr, int tid) {
    __syncthreads();
#pragma unroll
    for (int j = 0; j < 4; ++j) { const int f = tid + 512 * j, k = f >> 4, c = (f & 15) * 4;
        const f32x4 v = *(const f32x4*)(W + (size_t)(k0 + k) * N + n0 + c);
        const float g = (kgain ? kgain[k0 + k] : 1.0f) * sc;
#pragma unroll
        for (int q = 0; q < 4; ++q) ((LAS unsigned short*)scr)[(c + q) * 136 + k] = (unsigned short)f2bf(v[q] * g); }
    __syncthreads();
#pragma unroll
    for (int j = 0; j < 2; ++j) { const int ch = tid + 512 * j, n = ch >> 4, kc = ch & 15;
        const u32x4 o = *(const LAS u32x4*)(scr + n * 272 + kc * 16);
        *(u32x4*)(dst + (size_t)rm(n0 + n) * Kdst + k0 + kc * 8) = o; }
    __syncthreads();
}
struct RmId { static constexpr bool TILE_SCALE = false; int off; bool nt_out = false; __device__ __forceinline__ int operator()(int n) const { return n + off; } };
struct RmGu { static constexpr bool TILE_SCALE = true; static constexpr bool nt_out = true; __device__ __forceinline__ int operator()(int n) const { const int j = n >> 1; return (j >> 7) * 256 + (n & 1) * 128 + (j & 127); } };

template <class RowMap>
__device__ __forceinline__ void p0_quant_item(const float* W, int ldw, int n0, const float* kgain, signed char* dst, float* cb, RowMap rm, LAS unsigned char* scr, int tid, const LAS float* lgain = nullptr) {
    asm volatile("" : "+v"(tid));
    const int i16 = tid & 15, c = i16 * 4, kg = tid >> 4, lane = tid & 63, w = tid >> 6;
    const float* Wp = W + n0 + c;
    const unsigned rb = (unsigned)(4 * kg) * (unsigned)ldw;
    constexpr int PF = 3;
    f32x4 v[8][4]; unsigned pk[8][4][2]; float mx[4] = {0.f, 0.f, 0.f, 0.f};
#pragma unroll
    for (int jj = 0; jj < 8 + PF; ++jj) {
        if (jj < 8) {
#pragma unroll
            for (int i = 0; i < 4; ++i) v[jj][i] = __builtin_nontemporal_load((const f32x4*)(Wp + (rb + (unsigned)(128 * jj + i) * (unsigned)ldw))); }
        asm volatile("" ::: "memory");
        if (jj >= PF) { const int j = jj - PF;
            f32x4 g = (f32x4){1.f, 1.f, 1.f, 1.f};
            if (lgain) g = *(const LAS f32x4*)(lgain + 4 * kg + 128 * j); else if (kgain) g = *(const f32x4*)(kgain + 4 * kg + 128 * j);
#pragma unroll
            for (int i = 0; i < 4; ++i) { v[j][i] = v[j][i] * g[i];
#pragma unroll
                for (int q = 0; q < 4; ++q) mx[q] = fmaxf(mx[q], fabsf(v[j][i][q])); }
#pragma unroll
            for (int q = 0; q < 4; ++q) { pk[j][q][0] = cvt_pk_bf16(v[j][0][q], v[j][1][q]); pk[j][q][1] = cvt_pk_bf16(v[j][2][q], v[j][3][q]); } }
    }
#pragma unroll
    for (int q = 0; q < 4; ++q) { mx[q] = fmaxf(mx[q], __shfl_xor(mx[q], 16)); mx[q] = fmaxf(mx[q], __shfl_xor(mx[q], 32)); }
    LAS float* CMX = (LAS float*)(scr + 65536);
    if ((lane >> 4) == 0) *(LAS f32x4*)(CMX + w * 64 + c) = (f32x4){mx[0], mx[1], mx[2], mx[3]};
    __syncthreads();
    f32x4 cm = *(const LAS f32x4*)(CMX + c);
#pragma unroll
    for (int i = 1; i < 8; ++i) { const f32x4 o = *(const LAS f32x4*)(CMX + i * 64 + c); cm[0] = fmaxf(cm[0], o[0]); cm[1] = fmaxf(cm[1], o[1]); cm[2] = fmaxf(cm[2], o[2]); cm[3] = fmaxf(cm[3], o[3]); }
    if (RowMap::TILE_SCALE) {
        float m = fmaxf(fmaxf(cm[0], cm[1]), fmaxf(cm[2], cm[3]));
#pragma unroll
        for (int o = 1; o < 16; o <<= 1) m = fmaxf(m, __shfl_xor(m, o));
        cm = (f32x4){m, m, m, m}; }
    if (kg == 0) {
#pragma unroll
        for (int q = 0; q < 4; ++q) cb[rm(n0 + c + q)] = cm[q] * (1.0f / 127.0f); }
    constexpr float MAGIC = 12582912.0f;
#pragma unroll
    for (int q = 0; q < 4; ++q) { const float qs = cm[q] > 0.f ? 127.0f / cm[q] : 0.f;
        LAS unsigned char* rowp = scr + (c + q) * 1024;
#pragma unroll
        for (int j = 0; j < 8; ++j) {
            const unsigned f0 = __builtin_bit_cast(unsigned, fmaf(bflo(pk[j][q][0]), qs, MAGIC)), f1 = __builtin_bit_cast(unsigned, fmaf(bfhi(pk[j][q][0]), qs, MAGIC));
            const unsigned f2 = __builtin_bit_cast(unsigned, fmaf(bflo(pk[j][q][1]), qs, MAGIC)), f3 = __builtin_bit_cast(unsigned, fmaf(bfhi(pk[j][q][1]), qs, MAGIC));
            const unsigned wd = __builtin_amdgcn_perm(f1, f0, 0x0c0c0400u) | __builtin_amdgcn_perm(f3, f2, 0x04000c0cu);
            *(LAS unsigned*)(rowp + (((kg + 32 * j) ^ (i16 << 2)) << 2)) = wd; } }
    __syncthreads();
#pragma unroll
    for (int r = 0; r < 8; ++r) { const int n = 8 * w + r;
        const u32x4 o = *(const LAS u32x4*)(scr + n * 1024 + ((lane ^ ((n >> 2) & 15)) << 4));
        u32x4* dp_ = (u32x4*)(dst + (size_t)rm(n0 + n) * 1024 + lane * 16); if (rm.nt_out) __builtin_nontemporal_store(o, dp_); else *dp_ = o; }
}
__device__ __forceinline__ void p0_prologue(Frame& F) {
    LAS unsigned char* scr = F.lds;
    const int tid = F.tid;
    { LAS float* lg = (LAS float*)(scr + MISC_OFF + 512); for (int i = tid; i < 1024; i += 512) lg[i] = F.in[23][i]; }
    __syncthreads();
    constexpr int I_IN = 80, I_OUT = 16 * 16, I_Q = 16, I_KV = 32, I_O = 8 * 16, I_GU = 32 * 32, I_DN = 32 * 16;
    constexpr int NITEMS = I_IN + I_OUT + I_Q + I_KV + I_O + I_GU + I_DN;
    const bool rows_first = (F.vcu & 1) != 0;
    const int gw = F.vcu * 8 + F.wave, NGW = F.G * 8, lane = F.lane;
    for (int st_ = 0; st_ < 2; ++st_) {
    if ((st_ == 0) != rows_first) {
    for (int rep0_ = 0; rep0_ < ((REP0 & 1) ? 2 : 1); ++rep0_)
    for (int it = F.vcu; it < NITEMS; it += F.G) {
        int r = it; if ((REP0 & 4) && !(r >= I_IN + I_OUT + I_Q + I_KV + I_O && r < I_IN + I_OUT + I_Q + I_KV + I_O + I_GU) && rep0_) continue; if ((REP0 & 8) && !(r >= I_IN + I_OUT + I_Q + I_KV + I_O + I_GU) && rep0_) continue;
        if (r < I_IN) { const int nb = r; const int n0 = nb < 48 ? 64 * nb : 3088 + 64 * (nb - 48);
            p0_quant_item(F.in[3], 5136, n0, nullptr, (signed char*)(F.ws + WS_WIN), WSP(float, WS_CBIN), RmId{nb < 48 ? 0 : -16}, scr, tid); continue; } r -= I_IN;
        if (r < I_OUT) { const int kb = r / 16, nb = r % 16; p0_tr_item(F.in[17], 1024, 128 * kb, 64 * nb, kb < 8 ? F.in[9] : nullptr, 1.0f, WSP(bf16_t, WS_WOUT), 2048, RmId{0}, scr, tid); continue; } r -= I_OUT;
        if (r < I_Q) { p0_quant_item(F.in[20], 1024, 64 * r, F.in[18], (signed char*)(F.ws + WS_WQ), WSP(float, WS_CBQ), RmId{0}, scr, tid); continue; } r -= I_Q;
        if (r < I_KV) { const int nb = r; p0_quant_item(F.in[21], 2048, 64 * nb, nullptr, (signed char*)(F.ws + WS_WK), WSP(float, WS_CBKV), RmId{0}, scr, tid); continue; } r -= I_KV;
        if (r < I_O) { const int kb = r / 16, nb = r % 16; p0_tr_item(F.in[22], 1024, 128 * kb, 64 * nb, nullptr, 1.0f, WSP(bf16_t, WS_WO), 1024, RmId{0}, scr, tid); continue; } r -= I_O;
        if (r < I_GU) { const int e = r / 32, nb = r % 32;
            p0_quant_item(F.in[26] + (size_t)e * 1024 * 2048, 2048, 64 * nb, F.in[23], (signed char*)(F.ws + WS_WGU) + (size_t)e * 2048 * 1024, WSP(float, WS_CB) + (size_t)e * 2048, RmGu{}, scr, tid, (const LAS float*)(scr + MISC_OFF + 512)); continue; } r -= I_GU;
        { const int e = r / 16, nb = r % 16;
            p0_quant_item(F.in[28] + (size_t)e * 1024 * 1024, 1024, 64 * nb, nullptr, (signed char*)(F.ws + WS_WD) + (size_t)e * 1024 * 1024, WSP(float, WS_CBD) + (size_t)e * 1024, RmId{0, true}, scr, tid); }
    }
    { const int gt = F.vcu * 512 + tid, GT = F.G * 512;
      for (int i = gt; i < 32 * 1024; i += GT) { const int e = i >> 10, k = i & 1023; WSP(float, WS_WR)[i] = F.in[24][(size_t)k * 32 + e] * F.in[23][k]; } }
    for (int m = gw; m < MT; m += NGW) {
        const f32x4* xr = (const f32x4*)(F.in[1] + (size_t)m * D) + lane; const f32x4* gp = (const f32x4*)F.in[19] + lane;
        f32x4 v[4]; float s = 0.f;
#pragma unroll
        for (int j = 0; j < 4; ++j) { v[j] = xr[64 * j]; s += (v[j][0] * v[j][0] + v[j][1] * v[j][1]) + (v[j][2] * v[j][2] + v[j][3] * v[j][3]); }
        const float rs = rsqrtf(wave_sum(s) * (1.0f / D) + EPS);
        float mx = 0.f; const f32x4 gq[4] = {gp[0], gp[64], gp[128], gp[192]};
#pragma unroll
        for (int j = 0; j < 4; ++j) { v[j] = v[j] * rs * gq[j]; mx = fmaxf(mx, fmaxf(fmaxf(fabsf(v[j][0]), fabsf(v[j][1])), fmaxf(fabsf(v[j][2]), fabsf(v[j][3])))); }
#pragma unroll
        for (int o = 1; o < 64; o <<= 1) mx = fmaxf(mx, __shfl_xor(mx, o));
        const float qs = mx > 0.f ? 127.0f / mx : 0.f; unsigned* mq = (unsigned*)(F.ws + WS_MNB) + (size_t)m * 256 + lane;
#pragma unroll
        for (int j = 0; j < 4; ++j) mq[64 * j] = pack_i8x4(v[j][0] * qs, v[j][1] * qs, v[j][2] * qs, v[j][3] * qs);
        if (lane == 0) WSP(float, WS_MSC)[m] = mx * (1.0f / 127.0f);
    }
    } else {
    __syncthreads();
    LAS float* wdt = (LAS float*)F.lds;
    __syncthreads();
    for (int i = tid; i < 16 * 1024; i += 512) { const int o = i & 15, k = i >> 4; wdt[o * 1028 + k] = F.in[3][(size_t)k * 5136 + 3072 + o]; }
    __syncthreads();
    { const int ob = ((lane >> 5) & 1) * 8 + ((lane >> 4) & 1) * 4 + ((lane >> 3) & 1) * 2 + ((lane >> 2) & 1); const float dtb = F.in[6][ob];
      for (int rep1_ = 0; rep1_ < ((REP0 & 2) ? 2 : 1); ++rep1_)
#pragma unroll 1
      for (int m0 = gw; m0 < T; m0 += 2 * NGW) {
        int ln = lane; asm volatile("" : "+v"(ln));
        f32x4 v[2][4]; float s[2] = {0.f, 0.f}; const int m1 = (m0 + NGW < T) ? m0 + NGW : m0;
#pragma unroll
        for (int rr = 0; rr < 2; ++rr) { const int m = rr ? m1 : m0; const f32x4* xr = (const f32x4*)(F.in[0] + (size_t)m * D) + ln;
#pragma unroll
            for (int j = 0; j < 4; ++j) v[rr][j] = __builtin_nontemporal_load(xr + 64 * j); }
#pragma unroll
        for (int rr = 0; rr < 2; ++rr)
#pragma unroll
            for (int j = 0; j < 4; ++j) s[rr] += (v[rr][j][0] * v[rr][j][0] + v[rr][j][1] * v[rr][j][1]) + (v[rr][j][2] * v[rr][j][2] + v[rr][j][3] * v[rr][j][3]);
        float rs[2], mx[2] = {0.f, 0.f};
        f32x2 vp[4][4];
        { const f32x4* gp = (const f32x4*)F.in[2] + ln;
          s[0] = wave_sum(s[0]); s[1] = wave_sum(s[1]); rs[0] = rsqrtf(s[0] * (1.0f / D) + EPS); rs[1] = rsqrtf(s[1] * (1.0f / D) + EPS);
          const f32x2 rs2 = (f32x2){rs[0], rs[1]};
#pragma unroll
          for (int j = 0; j < 4; ++j) { const f32x4 g = gp[64 * j];
#pragma unroll
              for (int i = 0; i < 4; ++i) { vp[j][i] = ((f32x2){v[0][j][i], v[1][j][i]} * rs2) * g[i]; mx[0] = fmaxf(mx[0], fabsf(vp[j][i][0])); mx[1] = fmaxf(mx[1], fabsf(vp[j][i][1])); } }
#pragma unroll
          for (int o = 1; o < 64; o <<= 1) { mx[0] = fmaxf(mx[0], __shfl_xor(mx[0], o)); mx[1] = fmaxf(mx[1], __shfl_xor(mx[1], o)); } }
#pragma unroll
        for (int rr = 0; rr < 2; ++rr) {
            const int m = rr ? m1 : m0;
            const float qs = mx[rr] > 0.f ? 127.0f / mx[rr] : 0.f; unsigned* hq = (unsigned*)(F.ws + WS_HN) + (size_t)m * 256 + ln;
#pragma unroll
            for (int j = 0; j < 4; ++j) hq[64 * j] = pack_i8x4(vp[j][0][rr] * qs, vp[j][1][rr] * qs, vp[j][2][rr] * qs, vp[j][3][rr] * qs);
            if (ln == 0) WSP(float, WS_RSC)[m] = mx[rr] * (1.0f / 127.0f); }
        float p[2][16];
#pragma unroll
        for (int o = 0; o < 16; ++o) { const LAS f32x4* wp = (const LAS f32x4*)(wdt + o * 1028) + ln; f32x2 acc = (f32x2){0.f, 0.f};
#pragma unroll
            for (int j = 0; j < 4; ++j) { const f32x4 w = wp[64 * j];
#pragma unroll
                for (int i = 0; i < 4; ++i) acc = vp[j][i] * w[i] + acc; }
            p[0][o] = acc[0]; p[1][o] = acc[1]; if ((o & 3) == 3) asm volatile("" ::: "memory"); }
#pragma unroll
        for (int rr = 0; rr < 2; ++rr) {
#pragma unroll
            for (int i = 0; i < 8; ++i) { const bool hi = (ln & 32) != 0; const float snd = hi ? p[rr][i] : p[rr][i + 8], kp = hi ? p[rr][i + 8] : p[rr][i]; p[rr][i] = kp + __shfl_xor(snd, 32); }
#pragma unroll
            for (int i = 0; i < 4; ++i) { const bool hi = (ln & 16) != 0; const float snd = hi ? p[rr][i] : p[rr][i + 4], kp = hi ? p[rr][i + 4] : p[rr][i]; p[rr][i] = kp + __shfl_xor(snd, 16); }
#pragma unroll
            for (int i = 0; i < 2; ++i) { const bool hi = (ln & 8) != 0; const float snd = hi ? p[rr][i] : p[rr][i + 2], kp = hi ? p[rr][i + 2] : p[rr][i]; p[rr][i] = kp + __shfl_xor(snd, 8); }
            { const bool hi = (ln & 4) != 0; const float snd = hi ? p[rr][0] : p[rr][1], kp = hi ? p[rr][1] : p[rr][0]; p[rr][0] = kp + __shfl_xor(snd, 4); }
            p[rr][0] += __shfl_xor(p[rr][0], 2); p[rr][0] += __shfl_xor(p[rr][0], 1);
            if ((ln & 3) == 0) WSP(float, WS_DTV)[(size_t)(rr ? m1 : m0) * 16 + ob] = softplusf_(p[rr][0] + dtb);
        }
      }
    }
    __syncthreads();
    }
    }
    __syncthreads();
}

__device__ __forceinline__ void p2_conv(Frame& F) {
    const bf16_t* proj = WSP(bf16_t, WS_PROJ); bf16_t* cv = WSP(bf16_t, WS_CV); const __amdgpu_buffer_rsrc_t cvrs_ = __builtin_amdgcn_make_buffer_rsrc((void*)(cv), 0, 0x7fffffff, 0x00020000);
    for (int cidx = F.vcu; cidx < T / 64; cidx += F.G) {
        const int t0 = cidx * 64, cin = cidx & 63;
        for (int task = F.tid; task < 1024; task += 512) {
            const int v = task % 256, sub = task / 256, ch0 = 8 * v; const bool ssd = true;
            const float* wsrc = ssd ? F.in[4] + ch0 : F.in[10] + (ch0 - 2048); const int wn = ssd ? 2048 : 1024;
            const float* bsrc = ssd ? F.in[5] + ch0 : F.in[11] + (ch0 - 2048);
            float w[4][8], bias[8];
#pragma unroll
            for (int k = 0; k < 4; ++k) { const f32x4 a = *(const f32x4*)(wsrc + (size_t)k * wn), b = *(const f32x4*)(wsrc + (size_t)k * wn + 4);
                w[k][0] = a[0]; w[k][1] = a[1]; w[k][2] = a[2]; w[k][3] = a[3]; w[k][4] = b[0]; w[k][5] = b[1]; w[k][6] = b[2]; w[k][7] = b[3]; }
            { const f32x4 a = *(const f32x4*)bsrc, b = *(const f32x4*)(bsrc + 4); bias[0] = a[0]; bias[1] = a[1]; bias[2] = a[2]; bias[3] = a[3]; bias[4] = b[0]; bias[5] = b[1]; bias[6] = b[2]; bias[7] = b[3]; }
            const int ts = t0 + 16 * sub;
            const bf16_t* src = proj + (size_t)ts * NPROJ + PC_X + ch0;
            const bool first = (cin == 0 && sub == 0);
            u32x4 rw[19];
#pragma unroll
            for (int i = 0; i < 19; ++i) rw[i] = (i < 3 && first) ? (u32x4){0u, 0u, 0u, 0u} : *(const u32x4*)(src + (ptrdiff_t)(i - 3) * NPROJ);
#pragma unroll
            for (int r = 0; r < 16; ++r) { float y[8];
#pragma unroll
                for (int j = 0; j < 4; ++j) {
                    float a0 = bias[2 * j] + w[0][2 * j] * bflo(rw[r][j]) + w[1][2 * j] * bflo(rw[r + 1][j]) + w[2][2 * j] * bflo(rw[r + 2][j]) + w[3][2 * j] * bflo(rw[r + 3][j]);
                    float a1 = bias[2 * j + 1] + w[0][2 * j + 1] * bfhi(rw[r][j]) + w[1][2 * j + 1] * bfhi(rw[r + 1][j]) + w[2][2 * j + 1] * bfhi(rw[r + 2][j]) + w[3][2 * j + 1] * bfhi(rw[r + 3][j]);
                    y[2 * j] = ssd ? siluf_(a0) : a0; y[2 * j + 1] = ssd ? siluf_(a1) : a1; }
                u32x4 o; o.x = cvt_pk_bf16(y[0], y[1]); o.y = cvt_pk_bf16(y[2], y[3]); o.z = cvt_pk_bf16(y[4], y[5]); o.w = cvt_pk_bf16(y[6], y[7]);
                __builtin_amdgcn_raw_buffer_store_b128(o, cvrs_, (unsigned)(((ts + r) * NCV + ch0) * 2), 0, 16);
            }
        }
#pragma unroll
        for (int hh = 0; hh < 2; ++hh) { const int h = 2 * F.wave + hh; const float a = -__expf(F.in[7][h]);
            float val = WSP(float, WS_DTV)[(size_t)(t0 + F.lane) * 16 + h] * a;
#pragma unroll
            for (int o = 1; o < 64; o <<= 1) { const float up = __shfl_up(val, o); if (F.lane >= o) val += up; }
            WSP(float, WS_ACS)[(size_t)(t0 + F.lane) * 16 + h] = val; }
    }
}

__device__ __forceinline__ f32x4 zero4() { f32x4 z = (f32x4){0.f, 0.f, 0.f, 0.f}; asm volatile("" : "+v"(z)); return z; }
typedef short s16x4 __attribute__((ext_vector_type(4)));
__device__ __forceinline__ bf16x8 ldsfrag_tr(const LAS unsigned char* base, int kbase, int c0, int pitch_b, int lane) {
    const int j = lane & 15, fq = lane >> 4, q = j >> 2, pp = j & 3;
    const LAS unsigned char* a = base + (kbase + 8 * fq + q) * pitch_b + (c0 + 4 * pp) * 2;
    const s16x4 lo = __builtin_amdgcn_ds_read_tr16_b64_v4i16((LAS s16x4*)a);
    const s16x4 hi = __builtin_amdgcn_ds_read_tr16_b64_v4i16((LAS s16x4*)(a + 4 * pitch_b));
    return (bf16x8){lo[0], lo[1], lo[2], lo[3], hi[0], hi[1], hi[2], hi[3]};
}
__device__ __forceinline__ bf16x8 ldsfrag(const LAS unsigned char* base, int row, int pitch_b, int kbyte) { return *(const LAS bf16x8*)(base + row * pitch_b + kbyte); }

#define WG_BAR() do { asm volatile("s_waitcnt lgkmcnt(0)" ::: "memory"); __builtin_amdgcn_s_barrier(); asm volatile("" ::: "memory"); } while (0)
__device__ __forceinline__ void p3_ssd_unit(Frame& F, int b, int h) {
    constexpr int XO = 0, XW = 9216, BMo = 18432, CMo = 35840, MMo = 53248, STo = 62464, VEC = 79872;
    constexpr int P72 = 144, P136 = 272;
    LAS unsigned char* L = F.lds;
    LAS float* vss = (LAS float*)(L + VEC) + 192;
    int lane_ = F.lane; asm volatile("" : "+v"(lane_));
    const int lane = lane_, w = F.wave, tid = w * 64 + lane, fr = lane & 15, fq = lane >> 4, g = h >> 2;
    const bf16_t* cv = WSP(bf16_t, WS_CV); const bf16_t* proj = WSP(bf16_t, WS_PROJ); bf16_t* ycat = WSP(bf16_t, WS_YCAT);
    const float* dtv = WSP(float, WS_DTV); const float* acsg = WSP(float, WS_ACS); float* ssq = WSP(float, WS_SSQ);
    const float Dh = F.in[8][h];
    for (int i = tid; i < (9216 + 17408) / 4; i += 512) ((LAS unsigned*)(L + MMo))[i] = 0u;
    f32x4 sacc[4];
#pragma unroll
    for (int i = 0; i < 4; ++i) sacc[i] = (f32x4){0.f, 0.f, 0.f, 0.f};
    const int lt = w >> 1, ptb = 2 * (w & 1);
    float gmask[2][4];
#pragma unroll
    for (int q2 = 0; q2 < 2; ++q2) { const int q = 2 * w + q2, it = q >> 2, jt = q & 3;
#pragma unroll
        for (int r = 0; r < 4; ++r) gmask[q2][r] = (16 * jt + 4 * fq + r <= 16 * it + fr) ? 1.0f : 0.0f; }
    const int sl = tid >> 3, spc = tid & 7;
    u32x4 pxv, pbv[2], pcv[2]; u32x2 pzz[2]; float pdl, pal, pa63;
#define SSD_LOAD(c_) do { const int t0_ = b * SEQ + 64 * (c_); \
        pxv = *(const u32x4*)(cv + (size_t)(t0_ + sl) * NCV + h * 64 + 8 * spc); \
        pa63 = acsg[(size_t)(t0_ + 63) * 16 + h]; pdl = dtv[(size_t)(t0_ + sl) * 16 + h]; pal = acsg[(size_t)(t0_ + sl) * 16 + h]; \
        _Pragma("unroll") for (int jj = 0; jj < 2; ++jj) { const int idx = tid + 512 * jj, l2 = idx >> 4, nc = idx & 15; \
            pbv[jj] = *(const u32x4*)(cv + (size_t)(t0_ + l2) * NCV + 1024 + g * 128 + 8 * nc); pcv[jj] = *(const u32x4*)(cv + (size_t)(t0_ + l2) * NCV + 1536 + g * 128 + 8 * nc); } \
        _Pragma("unroll") for (int pp = 0; pp < 2; ++pp) pzz[pp] = *(const u32x2*)(proj + (size_t)(t0_ + 16 * lt + fr) * NPROJ + h * 64 + 16 * (ptb + pp) + 4 * fq); } while (0)
    constexpr int DB2 = 81920, VEC2 = 135168;
    float dec_n; u32x2 zn0, zn1;
    auto stage = [&](const int pb, const int vb) __attribute__((always_inline)) {
        LAS float* sdt = (LAS float*)(L + vb); LAS float* sacs = sdt + 64; LAS float* sea = sdt + 128;
        dec_n = __expf(pa63); zn0 = pzz[0]; zn1 = pzz[1];
        asm volatile("" : "+v"(dec_n), "+v"(zn0), "+v"(zn1));
        const float wl = pdl * __expf(pa63 - pal);
        if (spc == 0) { sdt[sl] = pdl; sacs[sl] = pal; sea[sl] = __expf(pal); }
        *(LAS u32x4*)(L + pb + XO + sl * P72 + 16 * spc) = pxv;
        u32x4 xw; xw.x = cvt_pk_bf16(bflo(pxv.x) * wl, bfhi(pxv.x) * wl); xw.y = cvt_pk_bf16(bflo(pxv.y) * wl, bfhi(pxv.y) * wl); xw.z = cvt_pk_bf16(bflo(pxv.z) * wl, bfhi(pxv.z) * wl); xw.w = cvt_pk_bf16(bflo(pxv.w) * wl, bfhi(pxv.w) * wl);
        *(LAS u32x4*)(L + pb + XW + sl * P72 + 16 * spc) = xw;
#pragma unroll
        for (int jj = 0; jj < 2; ++jj) { const int idx = tid + 512 * jj, l2 = idx >> 4, nc = idx & 15;
            *(LAS u32x4*)(L + pb + BMo + l2 * P136 + 16 * nc) = pbv[jj]; *(LAS u32x4*)(L + pb + CMo + l2 * P136 + 16 * nc) = pcv[jj]; } };
    SSD_LOAD(0);
    __syncthreads();
    stage(0, VEC);
    WG_BAR();
    for (int c = 0; c < 64; ++c) {
        const int t0 = b * SEQ + 64 * c;
        if (c + 1 < 64) SSD_LOAD(c + 1);
        const int PB = (c & 1) ? DB2 : 0;
        LAS float* vdt = (LAS float*)(L + ((c & 1) ? VEC2 : VEC)); LAS float* vacs = vdt + 64; LAS float* vea = vdt + 128;
        const float dec = dec_n; const u32x2 zc0 = zn0, zc1 = zn1;
        bf16x8 cfr[4];
#pragma unroll
        for (int kk = 0; kk < 4; ++kk) cfr[kk] = ldsfrag(L + PB + CMo, 16 * lt + fr, P136, 64 * kk + 16 * fq);
#pragma unroll
        for (int q2 = 0; q2 < 2; ++q2) { const int q = 2 * w + q2, it = q >> 2, jt = q & 3;
            if (jt <= it) { f32x4 a4 = zero4();
#pragma unroll
                for (int kk = 0; kk < 4; ++kk) a4 = __builtin_amdgcn_mfma_f32_16x16x32_bf16(ldsfrag(L + PB + BMo, 16 * jt + fr, P136, 64 * kk + 16 * fq), cfr[kk], a4, 0, 0, 0);
                const int l = 16 * it + fr, s0 = 16 * jt + 4 * fq; const float al = vacs[l]; float mv[4];
                const f32x4 as4 = *(const LAS f32x4*)(vacs + s0), dt4 = *(const LAS f32x4*)(vdt + s0);
#pragma unroll
                for (int r = 0; r < 4; ++r) mv[r] = a4[r] * (__expf(fminf(al - as4[r], 0.f)) * dt4[r]) * gmask[q2][r];
                u32x2 o; o.x = cvt_pk_bf16(mv[0], mv[1]); o.y = cvt_pk_bf16(mv[2], mv[3]);
                *(LAS u32x2*)(L + MMo + l * P72 + 2 * s0) = o; } }
        f32x4 yacc[2];
#pragma unroll
        for (int pp = 0; pp < 2; ++pp) { const int pt = ptb + pp; f32x4 a4 = zero4();
#pragma unroll
            for (int kk = 0; kk < 4; ++kk) a4 = __builtin_amdgcn_mfma_f32_16x16x32_bf16(ldsfrag(L + STo, 16 * pt + fr, P136, 64 * kk + 16 * fq), cfr[kk], a4, 0, 0, 0);
            yacc[pp] = a4 * vea[16 * lt + fr]; }
        WG_BAR();
        float sq = 0.f;
        { const int l = 16 * lt + fr; const size_t row = (size_t)(t0 + l);
          bf16x8 mfr[2];
#pragma unroll
          for (int kk = 0; kk < 2; ++kk) if (kk == 0 || lt >= 2) mfr[kk] = ldsfrag(L + MMo, 16 * lt + fr, P72, 64 * kk + 16 * fq);
#pragma unroll
          for (int pp = 0; pp < 2; ++pp) { const int pt = ptb + pp; f32x4 a4 = yacc[pp];
#pragma unroll
              for (int kk = 0; kk < 2; ++kk) if (kk == 0 || lt >= 2) a4 = __builtin_amdgcn_mfma_f32_16x16x32_bf16(ldsfrag_tr(L + PB + XO, 32 * kk, 16 * pt, P72, lane), mfr[kk], a4, 0, 0, 0);
              const int p0 = 16 * pt + 4 * fq;
              const u32x2 zz = pp ? zc1 : zc0; const u32x2 xx = *(const LAS u32x2*)(L + PB + XO + l * P72 + 2 * p0);
              const float z[4] = {bflo(zz.x), bfhi(zz.x), bflo(zz.y), bfhi(zz.y)}; const float xv[4] = {bflo(xx.x), bfhi(xx.x), bflo(xx.y), bfhi(xx.y)}; float uv[4];
#pragma unroll
              for (int r = 0; r < 4; ++r) { const float y = a4[r] + xv[r] * Dh; uv[r] = y * siluf_(z[r]); sq += uv[r] * uv[r]; }
              u32x2 o; o.x = cvt_pk_bf16(uv[0], uv[1]); o.y = cvt_pk_bf16(uv[2], uv[3]);
              *(u32x2*)(ycat + row * 2048 + h * 64 + p0) = o; }
          sq += __shfl_xor(sq, 16); sq += __shfl_xor(sq, 32);
          if (fq == 0) vss[(w & 1) * 64 + l] = sq; }
        { bf16x8 bt[2];
#pragma unroll
          for (int kk = 0; kk < 2; ++kk) bt[kk] = ldsfrag_tr(L + PB + BMo, 32 * kk, 16 * w, P136, lane);
#pragma unroll
          for (int pt = 0; pt < 4; ++pt) { f32x4 a4 = sacc[pt] * dec;
#pragma unroll
              for (int kk = 0; kk < 2; ++kk) a4 = __builtin_amdgcn_mfma_f32_16x16x32_bf16(bt[kk], ldsfrag_tr(L + PB + XW, 32 * kk, 16 * pt, P72, lane), a4, 0, 0, 0);
              sacc[pt] = a4;
              u32x2 o; o.x = cvt_pk_bf16(a4[0], a4[1]); o.y = cvt_pk_bf16(a4[2], a4[3]);
              *(LAS u32x2*)(L + STo + (16 * pt + fr) * P136 + 2 * (16 * w + 4 * fq)) = o; } }
        if (c + 1 < 64) stage((c & 1) ? 0 : DB2, (c & 1) ? VEC : VEC2);
        WG_BAR();
        if (tid < 64) ssq[(size_t)(t0 + tid) * 16 + h] = vss[tid] + vss[64 + tid];
    }
#undef SSD_LOAD
    __syncthreads();
}

__device__ __forceinline__ void p3_lru_unit(Frame& F, int b, int jb) {
    constexpr int AC = 0, WT = 9216, ALo = 27648, ULo = 44032; constexpr int P72 = 144;
    LAS unsigned char* L = F.lds;
    LAS float* AL = (LAS float*)(L + ALo); LAS float* UL = (LAS float*)(L + ULo); LAS float* SEG = (LAS float*)(L + 60416);
    int lane_ = F.lane; asm volatile("" : "+v"(lane_));
    const int lane = lane_, w = F.wave, tid = w * 64 + lane, fr = lane & 15, fq = lane >> 4;
    const bf16_t* cv = WSP(bf16_t, WS_CV); const bf16_t* proj = WSP(bf16_t, WS_PROJ); bf16_t* ycat = WSP(bf16_t, WS_YCAT);
    for (int i = tid; i < 8192; i += 512) { const int o = i & 127, ii = i >> 7; const float v = o < 64 ? F.in[12][((size_t)jb * 64 + ii) * 64 + o] : F.in[14][((size_t)jb * 64 + ii) * 64 + (o - 64)];
        ((LAS unsigned short*)(L + WT))[o * 72 + ii] = (unsigned short)f2bf(v); }
    float cba[2][4], cbx[2][4], csp[2][4];
#pragma unroll
    for (int pp = 0; pp < 2; ++pp) { const int ot = (2 * w + pp) & 3;
#pragma unroll
        for (int r = 0; r < 4; ++r) { const int ch = jb * 64 + 16 * ot + 4 * fq + r; cba[pp][r] = F.in[13][ch]; cbx[pp][r] = F.in[15][ch]; csp[pp][r] = -8.0f * log1pf(__expf(-F.in[16][ch])); } }
    float hstate = 0.f;
    const int l = tid >> 3, cc = tid & 7;
    __syncthreads();
    bf16x8 wfa[2][2], wfx[2][2];
#pragma unroll
    for (int pp = 0; pp < 2; ++pp) { const int ot = (2 * w + pp) & 3;
#pragma unroll
        for (int kk = 0; kk < 2; ++kk) { wfa[pp][kk] = ldsfrag(L + WT, 16 * ot + fr, P72, 64 * kk + 16 * fq); wfx[pp][kk] = ldsfrag(L + WT, 64 + 16 * ot + fr, P72, 64 * kk + 16 * fq); } }
    float cw[4][8], cbias[8];
    { const float* wsrc = F.in[10] + jb * 64 + 8 * cc; const float* bsrc = F.in[11] + jb * 64 + 8 * cc;
#pragma unroll
      for (int k = 0; k < 4; ++k) { const f32x4 a = *(const f32x4*)(wsrc + (size_t)k * 1024), c4 = *(const f32x4*)(wsrc + (size_t)k * 1024 + 4);
          cw[k][0] = a[0]; cw[k][1] = a[1]; cw[k][2] = a[2]; cw[k][3] = a[3]; cw[k][4] = c4[0]; cw[k][5] = c4[1]; cw[k][6] = c4[2]; cw[k][7] = c4[3]; }
      const f32x4 a = *(const f32x4*)bsrc, c4 = *(const f32x4*)(bsrc + 4); cbias[0] = a[0]; cbias[1] = a[1]; cbias[2] = a[2]; cbias[3] = a[3]; cbias[4] = c4[0]; cbias[5] = c4[1]; cbias[6] = c4[2]; cbias[7] = c4[3]; }
    u32x4 prw[4], pgv;
#define LRU_LOAD(t_) do { const int t0_ = b * SEQ + 64 * (t_); \
        _Pragma("unroll") for (int i_ = 0; i_ < 4; ++i_) prw[i_] = ((t_) == 0 && l + i_ < 3) ? (u32x4){0u, 0u, 0u, 0u} : *(const u32x4*)(proj + (size_t)(t0_ + l + i_ - 3) * NPROJ + PC_XR + jb * 64 + 8 * cc); \
        pgv = *(const u32x4*)(proj + (size_t)(t0_ + l) * NPROJ + PC_GR + jb * 64 + 8 * cc); } while (0)
    const __amdgpu_buffer_rsrc_t ycrs_ = __builtin_amdgcn_make_buffer_rsrc((void*)(ycat), 0, 0x7fffffff, 0x00020000);
    constexpr int AC2 = 64512, AL2o = 73728, UL2o = 90112;
    u32x4 gv_n;
    auto stage = [&](const int aco) __attribute__((always_inline)) { u32x4 pxv; float y[8];
        gv_n = pgv;
#pragma unroll
        for (int j = 0; j < 4; ++j) {
            y[2 * j] = cbias[2 * j] + cw[0][2 * j] * bflo(prw[0][j]) + cw[1][2 * j] * bflo(prw[1][j]) + cw[2][2 * j] * bflo(prw[2][j]) + cw[3][2 * j] * bflo(prw[3][j]);
            y[2 * j + 1] = cbias[2 * j + 1] + cw[0][2 * j + 1] * bfhi(prw[0][j]) + cw[1][2 * j + 1] * bfhi(prw[1][j]) + cw[2][2 * j + 1] * bfhi(prw[2][j]) + cw[3][2 * j + 1] * bfhi(prw[3][j]); }
        pxv.x = cvt_pk_bf16(y[0], y[1]); pxv.y = cvt_pk_bf16(y[2], y[3]); pxv.z = cvt_pk_bf16(y[4], y[5]); pxv.w = cvt_pk_bf16(y[6], y[7]);
        *(LAS u32x4*)(L + aco + l * P72 + 16 * cc) = pxv; };
    LRU_LOAD(0);
    __syncthreads();
    stage(AC);
    WG_BAR();
    for (int tile = 0; tile < 64; ++tile) {
        const int t0 = b * SEQ + 64 * tile;
        if (tile + 1 < 64) LRU_LOAD(tile + 1);
        const u32x4 gv = gv_n;
        const int aco = (tile & 1) ? AC2 : AC;
        LAS float* ALp = (tile & 1) ? (LAS float*)(L + AL2o) : AL; LAS float* ULp = (tile & 1) ? (LAS float*)(L + UL2o) : UL;
#pragma unroll
        for (int pp = 0; pp < 2; ++pp) { const int pi = 2 * w + pp, tt = pi >> 2, ot = pi & 3; f32x4 aa = zero4(), ax = zero4();
#pragma unroll
            for (int kk = 0; kk < 2; ++kk) { const bf16x8 bfr = ldsfrag(L + aco, 16 * tt + fr, P72, 64 * kk + 16 * fq);
                aa = __builtin_amdgcn_mfma_f32_16x16x32_bf16(wfa[pp][kk], bfr, aa, 0, 0, 0);
                ax = __builtin_amdgcn_mfma_f32_16x16x32_bf16(wfx[pp][kk], bfr, ax, 0, 0, 0); }
            const int t = 16 * tt + fr, ch0 = 16 * ot + 4 * fq; f32x4 av, uv;
#pragma unroll
            for (int r = 0; r < 4; ++r) { const float rr = sigmoidf_(aa[r] + cba[pp][r]), ii = sigmoidf_(ax[r] + cbx[pp][r]); const float la = csp[pp][r] * rr;
                const float xc = bf2f(((const LAS unsigned short*)(L + aco))[t * 72 + ch0 + r]);
                const float a = __expf(la); av[r] = a; uv[r] = xc * ii * __builtin_amdgcn_sqrtf(fmaxf(fmaf(-a, a, 1.0f), 0.f)); }
            *(LAS f32x4*)(ALp + t * 64 + ch0) = av; *(LAS f32x4*)(ULp + t * 64 + ch0) = uv; }
        WG_BAR();
        float hreg[8], preg[8];
        { float hl = 0.f, pl = 1.f;
#pragma unroll
          for (int i = 0; i < 8; ++i) { const int t = 8 * w + i; const float a = ALp[t * 64 + lane], u = ULp[t * 64 + lane]; hl = a * hl + u; pl *= a; hreg[i] = hl; preg[i] = pl; }
          SEG[w * 64 + lane] = pl; SEG[512 + w * 64 + lane] = hl; }
        if (tile + 1 < 64) stage((tile & 1) ? AC : AC2);
        WG_BAR();
        { float c = hstate, cin = 0.f;
#pragma unroll
          for (int v = 0; v < 8; ++v) { if (v == w) cin = c; c = SEG[v * 64 + lane] * c + SEG[512 + v * 64 + lane]; }
          hstate = c;
#pragma unroll
          for (int i = 0; i < 8; ++i) ULp[(8 * w + i) * 64 + lane] = fmaf(preg[i], cin, hreg[i]); }
        asm volatile("s_waitcnt lgkmcnt(0)" ::: "memory");
        { const f32x4 h0 = *(const LAS f32x4*)(ULp + l * 64 + 8 * cc), h1 = *(const LAS f32x4*)(ULp + l * 64 + 8 * cc + 4);
          u32x4 o;
          o.x = cvt_pk_bf16(h0[0] * gelu_tanhf_(bflo(gv.x)), h0[1] * gelu_tanhf_(bfhi(gv.x))); o.y = cvt_pk_bf16(h0[2] * gelu_tanhf_(bflo(gv.y)), h0[3] * gelu_tanhf_(bfhi(gv.y)));
          o.z = cvt_pk_bf16(h1[0] * gelu_tanhf_(bflo(gv.z)), h1[1] * gelu_tanhf_(bfhi(gv.z))); o.w = cvt_pk_bf16(h1[2] * gelu_tanhf_(bflo(gv.w)), h1[3] * gelu_tanhf_(bfhi(gv.w)));
          __builtin_amdgcn_raw_buffer_store_b128(o, ycrs_, (unsigned)(((t0 + l) * 2048 + 1024 + jb * 64 + 8 * cc) * 2), 0, 16); }
    }
#undef LRU_LOAD
    __syncthreads();
}

__device__ __forceinline__ void p4_fixup(Frame& F) {
    const int gw = F.vcu * 8 + F.wave, NGW = F.G * 8, lane = F.lane;
    bf16_t* ycat = WSP(bf16_t, WS_YCAT); const float* ssq = WSP(float, WS_SSQ);
    for (int m = gw; m < T; m += NGW) {
#pragma unroll
        for (int jj = 0; jj < 2; ++jj) { const int col = 512 * jj + 8 * lane, g = col >> 8;
            const f32x4 s4 = *(const f32x4*)(ssq + (size_t)m * 16 + 4 * g);
            const float rs = rsqrtf(((s4[0] + s4[1]) + (s4[2] + s4[3])) * (1.0f / 256.0f) + EPS);
            u32x4* p = (u32x4*)(ycat + (size_t)m * 2048 + col); const u32x4 v = *p;
            const f32x4 g0 = *(const f32x4*)(F.in[9] + col), g1 = *(const f32x4*)(F.in[9] + col + 4);
            u32x4 o; o.x = cvt_pk_bf16(bflo(v.x) * rs * g0[0], bfhi(v.x) * rs * g0[1]); o.y = cvt_pk_bf16(bflo(v.y) * rs * g0[2], bfhi(v.y) * rs * g0[3]);
            o.z = cvt_pk_bf16(bflo(v.z) * rs * g1[0], bfhi(v.z) * rs * g1[1]); o.w = cvt_pk_bf16(bflo(v.w) * rs * g1[2], bfhi(v.w) * rs * g1[3]);
            *p = o; }
    }
}

__device__ __forceinline__ void p10_router(Frame& F) {
    LAS float* HT = (LAS float*)F.lds; LAS float* WTt = HT + 128 * 65; LAS float* LG = WTt + 64 * 32; LAS unsigned* SEL = (LAS unsigned*)(LG + 128 * 33); LAS float* RS = (LAS float*)(SEL + 128); LAS int* WBASE = (LAS int*)(RS + 128); LAS float* QS = (LAS float*)(WBASE + 32); LAS unsigned long long* EM = (LAS unsigned long long*)(QS + 128);
    const int tid = F.tid; const bf16_t* h2 = WSP(bf16_t, WS_H); const float* wr = WSP(float, WS_WR); const float* ss2 = WSP(float, WS_SS2);
    int* ltok = WSP(int, WS_LTOK); float* lgate = WSP(float, WS_LGATE); float* lrstd = WSP(float, WS_LRSTD); int* pair = WSP(int, WS_PAIR);
    for (int blk = F.vcu; blk < T / 128; blk += F.G) {
        const int tb = blk * 128; const int tt = tid >> 2, eq = tid & 3;
        typedef float f32x16 __attribute__((ext_vector_type(16)));
        f32x16 lacc;
#pragma unroll
        for (int i = 0; i < 16; ++i) lacc[i] = 0.f;
        const int mg = F.wave & 3, kh = F.wave >> 2, li = F.lane & 31, lk = F.lane >> 5;
        u32x2 hA[4], hB[4]; float wA[4], wB[4];
#define RT_LOAD(H_, W_, k0_) do { _Pragma("unroll") for (int j = 0; j < 4; ++j) { const int f = tid + 512 * j; H_[j] = *(const u32x2*)(h2 + (size_t)(tb + (f >> 4)) * D + (k0_) + (f & 15) * 4); W_[j] = wr[(size_t)(f >> 6) * D + (k0_) + (f & 63)]; } } while (0)
#define RT_STEP(H_, W_, k0_) do { __syncthreads(); \
            _Pragma("unroll") for (int j = 0; j < 4; ++j) { const int f = tid + 512 * j, r = f >> 4, c4 = (f & 15) * 4; \
                HT[r * 65 + c4] = bflo(H_[j].x); HT[r * 65 + c4 + 1] = bfhi(H_[j].x); HT[r * 65 + c4 + 2] = bflo(H_[j].y); HT[r * 65 + c4 + 3] = bfhi(H_[j].y); \
                WTt[(f & 63) * 32 + (f >> 6)] = W_[j]; } \
            __syncthreads(); \
            if ((k0_) + 128 < D) RT_LOAD(H_, W_, (k0_) + 128); \
            _Pragma("unroll 8") for (int s = 0; s < 16; ++s) { const int k = 32 * kh + 2 * s + lk; \
                lacc = __builtin_amdgcn_mfma_f32_32x32x2f32(HT[(32 * mg + li) * 65 + k], WTt[k * 32 + li], lacc, 0, 0, 0); } } while (0)
        RT_LOAD(hA, wA, 0); RT_LOAD(hB, wB, 64);
        if (tid < 128) { const f32x4* sp = (const f32x4*)(ss2 + (size_t)(tb + tid) * 16); const f32x4 s0 = sp[0], s1 = sp[1], s2 = sp[2], s3 = sp[3];
            const float tot = ((s0[0] + s0[1]) + (s0[2] + s0[3])) + ((s1[0] + s1[1]) + (s1[2] + s1[3])) + ((s2[0] + s2[1]) + (s2[2] + s2[3])) + ((s3[0] + s3[1]) + (s3[2] + s3[3]));
            RS[tid] = rsqrtf(tot * (1.0f / D) + EPS); }
#pragma unroll 1
        for (int k0 = 0; k0 < D; k0 += 128) { RT_STEP(hA, wA, k0); RT_STEP(hB, wB, k0 + 64); }
#undef RT_STEP
#undef RT_LOAD
        __syncthreads();
        { LAS float* PART = HT;
          if (kh == 1) {
#pragma unroll
              for (int r = 0; r < 16; ++r) PART[(32 * mg + (r & 3) + 8 * (r >> 2) + 4 * lk) * 33 + li] = lacc[r]; }
          __syncthreads();
          if (kh == 0) {
#pragma unroll
              for (int r = 0; r < 16; ++r) { const int tok = 32 * mg + (r & 3) + 8 * (r >> 2) + 4 * lk; LG[tok * 33 + li] = (lacc[r] + PART[tok * 33 + li]) * RS[tok] + F.in[25][li]; } }
        }
#pragma unroll 1
        for (int r0 = F.wave; r0 < 128; r0 += 32) { u32x2 hw[4][4];
#pragma unroll
            for (int q = 0; q < 4; ++q) { const u32x2* xr = (const u32x2*)(h2 + (size_t)(tb + r0 + 8 * q) * D) + F.lane;
#pragma unroll
                for (int j = 0; j < 4; ++j) hw[q][j] = xr[64 * j]; }
#pragma unroll
            for (int q = 0; q < 4; ++q) { const int r = r0 + 8 * q, row = tb + r; f32x4 v[4]; float mx = 0.f;
#pragma unroll
            for (int j = 0; j < 4; ++j) { const u32x2 hw_ = hw[q][j]; v[j] = (f32x4){bflo(hw_.x), bfhi(hw_.x), bflo(hw_.y), bfhi(hw_.y)}; mx = fmaxf(mx, fmaxf(fmaxf(fabsf(v[j][0]), fabsf(v[j][1])), fmaxf(fabsf(v[j][2]), fabsf(v[j][3])))); }
#pragma unroll
            for (int o = 1; o < 64; o <<= 1) mx = fmaxf(mx, __shfl_xor(mx, o));
            const float qs = mx > 0.f ? 127.0f / mx : 0.f; unsigned* hq = (unsigned*)(F.ws + WS_HQ) + (size_t)row * 256 + F.lane;
#pragma unroll
            for (int j = 0; j < 4; ++j) hq[64 * j] = pack_i8x4(v[j][0] * qs, v[j][1] * qs, v[j][2] * qs, v[j][3] * qs);
            if (F.lane == 0) QS[r] = mx * (1.0f / 127.0f); } }
        __syncthreads();
        int myidx[4]; float mygate[4];
#pragma unroll
        for (int k = 0; k < 4; ++k) { myidx[k] = 0; mygate[k] = 0.f; }
        if (tid < 128) {
            unsigned sel = 0u; float tv[4];
            float lgv[32];
#pragma unroll
            for (int e = 0; e < 32; ++e) lgv[e] = LG[tid * 33 + e];
#pragma unroll
            for (int k = 0; k < 4; ++k) { float best = -3.0e38f; int bi = 0;
#pragma unroll
                for (int e = 0; e < 32; ++e) { const float lv = lgv[e]; const bool ok = !((sel >> e) & 1u) && lv > best; best = ok ? lv : best; bi = ok ? e : bi; }
                sel |= 1u << bi; myidx[k] = bi; tv[k] = best; }
            const float e0 = 1.0f, e1 = __expf(tv[1] - tv[0]), e2 = __expf(tv[2] - tv[0]), e3 = __expf(tv[3] - tv[0]); const float inv = 1.0f / (e0 + e1 + e2 + e3);
            mygate[0] = e0 * inv; mygate[1] = e1 * inv; mygate[2] = e2 * inv; mygate[3] = e3 * inv;
            SEL[tid] = sel;
#pragma unroll
            for (int e = 0; e < 32; ++e) { const unsigned long long m_ = __ballot((sel >> e) & 1u); if (F.lane == 0) EM[(tid >> 6) * 32 + e] = m_; }
        }
        __syncthreads();
        int myrank[4];
#pragma unroll
        for (int k = 0; k < 4; ++k) myrank[k] = 0;
        if (tid < 128) { const int w_ = tid >> 6; const unsigned long long below = (1ull << F.lane) - 1ull;
#pragma unroll
            for (int k = 0; k < 4; ++k) myrank[k] = (int)__popcll(EM[w_ * 32 + myidx[k]] & below) + (w_ ? (int)__popcll(EM[myidx[k]]) : 0);
        }
#if ROUTER_TICKET
        if (tid == 0) { unsigned sp = 0; while (__hip_atomic_load(F.ctl + CW_TICKET, __ATOMIC_RELAXED, __HIP_MEMORY_SCOPE_AGENT) != (unsigned)blk) { __builtin_amdgcn_s_sleep(2); if (++sp > (1u << 22)) break; } }
        __syncthreads();
#endif
        if (tid >= 128 && tid < 160) { const int e = tid - 128; const int cnt = (int)__popcll(EM[e]) + (int)__popcll(EM[32 + e]);
            WBASE[e] = cnt > 0 ? (int)__hip_atomic_fetch_add(F.ctl + CW_CNT + 64 * e, (unsigned)cnt, __ATOMIC_RELAXED, __HIP_MEMORY_SCOPE_AGENT) : 0; }
        __syncthreads();
#if ROUTER_TICKET
        if (tid == 0) __hip_atomic_fetch_add(F.ctl + CW_TICKET, 1u, __ATOMIC_RELAXED, __HIP_MEMORY_SCOPE_AGENT);
#endif
        if (tid < 128) { const int tok = tb + tid; const float rs = RS[tid];
#pragma unroll
            for (int k = 0; k < 4; ++k) { const int e = myidx[k], pos = WBASE[e] + myrank[k];
                ltok[(size_t)e * T + pos] = tok; lgate[(size_t)e * T + pos] = mygate[k]; lrstd[(size_t)e * T + pos] = rs * QS[tid];
                pair[(size_t)tok * 8 + 2 * k] = e; pair[(size_t)tok * 8 + 2 * k + 1] = pos; } }
        __syncthreads();
    }
}
__device__ __forceinline__ void moe_tables(Frame& F, int npn) {
    LAS int* tab = (LAS int*)(F.lds + TAB_OFF);
    __syncthreads();
    if (F.wave == 0) { const int e = F.lane;
        const int c = e < 32 ? (int)__hip_atomic_load(F.ctl + CW_CNT + 64 * (e & 31), __ATOMIC_RELAXED, __HIP_MEMORY_SCOPE_AGENT) : 0;
        const int un = ((c + 255) >> 8) * npn; int rs = c, us = un;
#pragma unroll
        for (int o = 1; o < 64; o <<= 1) { const int t1 = __shfl_up(rs, o), t2 = __shfl_up(us, o); if (e >= o) { rs += t1; us += t2; } }
        if (e < 32) { tab[e] = rs - c; tab[64 + e] = us - un; }
        if (e == 31) { tab[32] = rs; tab[96] = us; } }
    __syncthreads();
}
__device__ __forceinline__ void moe_tables_halve(Frame& F) {
    LAS int* tab = (LAS int*)(F.lds + TAB_OFF);
    __syncthreads();
    if (F.tid <= 32) tab[64 + F.tid] >>= 1;
    __syncthreads();
}
__device__ __forceinline__ void p13_combine(Frame& F) {
    const LAS int* tab = (const LAS int*)(F.lds + TAB_OFF);
    const int gw = F.vcu * 8 + F.wave, NGW = F.G * 8, lane = F.lane;
    const bf16_t* yb = WSP(bf16_t, WS_YB); const int* pair = WSP(int, WS_PAIR);
#pragma unroll 1
    for (int m0 = gw; m0 < T; m0 += 2 * NGW) { const int m1 = (m0 + NGW < T) ? m0 + NGW : m0;
        const f32x4* gp = (const f32x4*)F.in[30] + lane;
        int pe[2][4], pq[2][4];
#pragma unroll
        for (int rr = 0; rr < 2; ++rr)
#pragma unroll
            for (int k = 0; k < 4; ++k) { const int m = rr ? m1 : m0; pe[rr][k] = pair[(size_t)m * 8 + 2 * k]; pq[rr][k] = pair[(size_t)m * 8 + 2 * k + 1]; }
        u32x2 hw[2][4]; int yv[2][4][4];
#pragma unroll
        for (int rr = 0; rr < 2; ++rr) { const int m = rr ? m1 : m0; const u32x2* hsrc = (const u32x2*)(WSP(bf16_t, WS_H) + (size_t)m * D) + lane;
#pragma unroll
            for (int j = 0; j < 4; ++j) hw[rr][j] = hsrc[64 * j];
#pragma unroll
            for (int k = 0; k < 4; ++k) { const size_t row = (size_t)(tab[pe[rr][k]] + pq[rr][k]);
                const int* yr = (const int*)((const unsigned char*)yb + row * D) + lane;
#pragma unroll
                for (int j = 0; j < 4; ++j) yv[rr][k][j] = yr[64 * j]; } }
#pragma unroll
        for (int rr = 0; rr < 2; ++rr) { const int m = rr ? m1 : m0; f32x4* hr = (f32x4*)(F.out + (size_t)m * D) + lane;
            f32x4 v[4];
#pragma unroll
            for (int j = 0; j < 4; ++j) v[j] = (f32x4){bflo(hw[rr][j].x), bfhi(hw[rr][j].x), bflo(hw[rr][j].y), bfhi(hw[rr][j].y)};
#pragma unroll
            for (int k = 0; k < 4; ++k)
#pragma unroll
                for (int j = 0; j < 4; ++j) { const int y = yv[rr][k][j]; const f32x2 lo = __builtin_amdgcn_cvt_pk_f32_fp8(y, false), hi = __builtin_amdgcn_cvt_pk_f32_fp8(y, true);
                    v[j][0] += lo[0]; v[j][1] += lo[1]; v[j][2] += hi[0]; v[j][3] += hi[1]; }
            float s = 0.f;
#pragma unroll
            for (int j = 0; j < 4; ++j) s += (v[j][0] * v[j][0] + v[j][1] * v[j][1]) + (v[j][2] * v[j][2] + v[j][3] * v[j][3]);
            const float rs = rsqrtf(wave_sum(s) * (1.0f / D) + EPS);
#pragma unroll
            for (int j = 0; j < 4; ++j) { const f32x4 g = gp[64 * j]; hr[64 * j] = v[j] * rs * g; } }
    }
}

struct Args { const float* in[31]; float* out; unsigned char* ws; int ph_lo, ph_hi, li, pad; };
__global__ void __launch_bounds__(512, 2) mk_fwd(Args args) {
    extern __shared__ __attribute__((aligned(16))) unsigned char lds_raw[];
    Frame F;
    F.lds = (LAS unsigned char*)lds_raw;
    F.tid = threadIdx.x; F.lane = F.tid & 63; F.wave = __builtin_amdgcn_readfirstlane(F.tid >> 6);
    F.G = gridDim.x; { const int bx = blockIdx.x; F.vcu = (F.G % 8 == 0) ? (bx % 8) * (F.G / 8) + bx / 8 : bx; }
#pragma unroll
    for (int i = 0; i < 31; ++i) F.in[i] = args.in[i];
    F.out = args.out; F.ws = args.ws; F.ctl = (unsigned*)(args.ws + WS_CTL);
    volatile LAS unsigned* MISC = (volatile LAS unsigned*)(F.lds + MISC_OFF);
    if (F.tid < 32) MISC[F.tid] = 0u;
    __syncthreads();
    XcdBarrier bar; bar.bar = F.ctl + CW_BAR; bar.x = 0; bar.st = nullptr;
    if (MK_N_LAUNCHES != NPHASE) bar = xcd_barrier_post(F.ctl + CW_BAR, MISC + 8);
    const int lo = args.ph_lo, hi = args.ph_hi;
#define IN(k) ((lo <= (k) && (k) < hi) && (F.lane = lane_id_(), F.tid = F.wave * 64 + F.lane, true))
#define SEAM(k) do { if (MK_N_LAUNCHES != NPHASE) { if (IN(k) && IN((k) + 1)) xcd_barrier(bar); } } while (0)
    const int bid = (int)blockIdx.x;

    if (IN(0)) _Pragma("unroll") for (int rep_ = 0; rep_ < NREP(0); ++rep_) p0_prologue(F);
    SEAM(0);
    if (IN(1)) _Pragma("unroll") for (int rep_ = 0; rep_ < NREP(1); ++rep_) {
        pg8::DenseSched S; S.init(T, NPROJ, F.G, bid, F.ws + WS_HN, F.ws + WS_WIN, 1024, 1024);
        EpiI8Scale E{WSP(bf16_t, WS_PROJ), NPROJ, WSP(float, WS_RSC), WSP(float, WS_CBIN)};
        pg8::gemm_phase<EpiI8Scale, pg8::DenseSched, false, true>(F.wave, F.lds, 1024, 1024, 512, S, E);
    }
    SEAM(1);
    if (IN(2)) _Pragma("unroll") for (int rep_ = 0; rep_ < NREP(2); ++rep_) p2_conv(F);
    SEAM(2);
    if (IN(3)) _Pragma("unroll") for (int rep_ = 0; rep_ < NREP(3); ++rep_) {
        for (int it = bid; it < 256; it += F.G) { const int x = it & 7, y = it >> 3;
            if (y < 16) { const int gi = x + 8 * (y >> 2), hin = y & 3; p3_ssd_unit(F, gi >> 2, 4 * (gi & 3) + hin); if (REP_SSD) p3_ssd_unit(F, gi >> 2, 4 * (gi & 3) + hin); }
            else { const int idx = x + 8 * (y - 16); p3_lru_unit(F, idx >> 4, idx & 15); if (REP_LRU) p3_lru_unit(F, idx >> 4, idx & 15); } }
    }
    if (IN(3)) {
        const int half = F.G >> 1;
        if (bid >= half) { KvSched S{F.G - half, bid - half, (const char*)(F.ws + WS_MNB), (const char*)(F.ws + WS_WK), (const char*)(F.ws + WS_WK + MiB)};
            EpiKVI8 E{WSP(bf16_t, WS_KM), WSP(bf16_t, WS_VT), WSP(float, WS_MSC), WSP(float, WS_CBKV)};
            pg8::gemm_phase<EpiKVI8, KvSched, false, true>(F.wave, F.lds, 1024, 1024, 512, S, E); }
    }
    SEAM(3);
    if (IN(5)) _Pragma("unroll") for (int rep_ = 0; rep_ < NREP(5); ++rep_) {
        pg8::DenseSched S; S.init(T, D, F.G, bid, WSP(bf16_t, WS_YCAT), WSP(bf16_t, WS_WOUT), 4096, 4096);
        EpiResid<2, false> E{F.in[0], WSP(bf16_t, WS_H), WSP(bf16_t, WS_HB), WSP(float, WS_SS1)};
        GnKHook KH{WSP(float, WS_SSQ)};
        pg8::gemm_phase<EpiResid<2, false>, pg8::DenseSched, false, false, GnKHook>(F.wave, F.lds, 4096, 4096, 2048, S, E, KH);
    }
    SEAM(5);
    if (IN(6)) _Pragma("unroll") for (int rep_ = 0; rep_ < NREP(6); ++rep_) {
        AttnSched S{F.G, bid, 2, (const char*)WSP(bf16_t, WS_HB), (const char*)(F.ws + WS_WQ)};
        EpiRowScaleI8 E{WSP(bf16_t, WS_Q), D, WSP(float, WS_SS1), WSP(float, WS_CBQ), (H1Q_CLIP / 127.0f) * 0.0625f};
        pg8::gemm_phase<EpiRowScaleI8, AttnSched, false, true>(F.wave, F.lds, 1024, 1024, 512, S, E);
    }
    if (MK_N_LAUNCHES == NPHASE) { SEAM(6); } else { VM_WAIT(); __syncthreads(); }
    if (IN(7)) _Pragma("unroll") for (int rep_ = 0; rep_ < NREP(7); ++rep_) {
        AttnSched S{F.G, bid, 0, (const char*)WSP(bf16_t, WS_Q), (const char*)WSP(bf16_t, WS_KM)};
        EpiSoftmax E{WSP(bf16_t, WS_P)};
        pg8::gemm_phase<EpiSoftmax, AttnSched, false>(F.wave, F.lds, 2048, 2048, 256, S, E);
    }
    if (MK_N_LAUNCHES == NPHASE) { SEAM(7); } else { VM_WAIT(); __syncthreads(); }
    if (IN(8)) _Pragma("unroll") for (int rep_ = 0; rep_ < NREP(8); ++rep_) {
        AttnSched S{F.G, bid, 1, (const char*)WSP(bf16_t, WS_P), (const char*)WSP(bf16_t, WS_VT)};
        EpiBf16 E{WSP(bf16_t, WS_Q), D, WSP(bf16_t, WS_Q), D};
        pg8::gemm_phase<EpiBf16, AttnSched, false>(F.wave, F.lds, 2048, 4096, 256, S, E);
    }
    SEAM(8);
    if (IN(9)) {
        pg8::DenseSched S; S.init(T, D, F.G, bid, WSP(bf16_t, WS_Q), WSP(bf16_t, WS_WO), 2048, 2048);
        EpiResid<0, true> E{WSP(bf16_t, WS_H), WSP(bf16_t, WS_H), WSP(bf16_t, WS_HB), WSP(float, WS_SS2)};
        pg8::gemm_phase<EpiResid<0, true>, pg8::DenseSched, false>(F.wave, F.lds, 2048, 2048, 1024, S, E);
    }
    SEAM(9);
    if (IN(10)) p10_router(F);
    SEAM(10);
    if (IN(11)) _Pragma("unroll") for (int rep_ = 0; rep_ < NREP(11); ++rep_) {
        moe_tables(F, 8);
        MoeSched S{F.G, bid, 8, 1, (const LAS int*)(F.lds + TAB_OFF), (const char*)(F.ws + WS_HQ), (const char*)(F.ws + WS_WGU), WSP(int, WS_LTOK), (size_t)2048 * 1024, 1024};
        EpiSwigluI8 E{WSP(bf16_t, WS_ACT), F.in[27], WSP(float, WS_LRSTD), WSP(float, WS_CB)};
        pg8::gemm_phase<EpiSwigluI8, MoeSched, true, true>(F.wave, F.lds, 1024, 1024, 512, S, E);
    }
    SEAM(11);
    if (IN(12)) _Pragma("unroll") for (int rep_ = 0; rep_ < NREP(12); ++rep_) {
        if (MK_N_LAUNCHES == NPHASE) moe_tables(F, 4); else moe_tables_halve(F);
        MoeSched S{F.G, bid, 4, 0, (const LAS int*)(F.lds + TAB_OFF), (const char*)(F.ws + WS_ACT), (const char*)(F.ws + WS_WD), WSP(int, WS_LTOK), (size_t)1024 * 1024, 1024};
        EpiDown E{WSP(bf16_t, WS_YB), F.in[29], WSP(float, WS_LGATE), WSP(float, WS_CBD)};
        pg8::gemm_phase<EpiDown, MoeSched, false, true>(F.wave, F.lds, 1024, 1024, 512, S, E);
    }
    SEAM(12);
    if (MK_N_LAUNCHES != NPHASE) { for (int xb_ = 0; xb_ < EXTRA_BARS; ++xb_) xcd_barrier(bar); }
    if (IN(13)) { if (MK_N_LAUNCHES == NPHASE) moe_tables(F, 4); else __syncthreads();
        p13_combine(F); }
#if DBG_DUMP
    if (IN(14)) {
        const bf16_t* src = DBG_DUMP == 1 ? WSP(bf16_t, WS_PROJ) : DBG_DUMP == 2 ? WSP(bf16_t, WS_CV) : DBG_DUMP == 3 ? WSP(bf16_t, WS_YCAT) : DBG_DUMP == 4 ? WSP(bf16_t, WS_Q) : DBG_DUMP == 5 ? WSP(bf16_t, WS_P) : DBG_DUMP == 6 ? WSP(bf16_t, WS_HB) : DBG_DUMP == 7 ? WSP(bf16_t, WS_ACT) : WSP(bf16_t, WS_YB);
        const int ld = DBG_DUMP == 1 ? 5120 : DBG_DUMP == 2 ? 3072 : DBG_DUMP == 3 ? 2048 : 1024;
#if DBG_DUMP == 11
        for (size_t i = (size_t)bid * 512 + F.tid; i < (size_t)T * D; i += (size_t)F.G * 512) { const size_t t = i >> 10; const int c = (int)(i & 15); F.out[i] = WSP(float, WS_DTV)[t * 16 + c] + 3.0f * WSP(float, WS_ACS)[t * 16 + c]; }
        if (0)
#endif
#if DBG_DUMP == 9 || DBG_DUMP == 10
        for (size_t i = (size_t)bid * 512 + F.tid; i < (size_t)T * D; i += (size_t)F.G * 512) { const size_t t = i >> 10; const int c = (int)(i & 1023); F.out[i] = bf2f(WSP(bf16_t, WS_YCAT)[t * 2048 + c + (DBG_DUMP == 9 ? 1024 : 0)]); }
        if (0)
#endif
        for (size_t i = (size_t)bid * 512 + F.tid; i < (size_t)T * D; i += (size_t)F.G * 512) { const size_t t = i >> 10; const int c = (int)(i & 1023); float s = 0.f;
            for (int j = 0; j < ld / 1024; ++j) s += bf2f(src[t * ld + c + 1024 * j]);
            F.out[i] = s; }
    }
#endif
#undef IN
#undef SEAM
}

extern "C" void kernel_launch(void* const* d_in, const int* in_sizes, int n_in, void* d_out, int out_size, void* d_ws, size_t ws_size, hipStream_t stream) {
    static int grid = 0;
    if (grid == 0) {
        if (n_in != 31 || in_sizes[0] != T * D || out_size != T * D || ws_size < WS_END) { fprintf(stderr, "kernel_launch: unexpected problem (n_in %d, in0 %d, out %d, ws %zu < %zu?)\n", n_in, n_in > 0 ? in_sizes[0] : -1, out_size, ws_size, (size_t)WS_END); grid = -1; return; }
        int dev = 0, cus = 0, per_cu = 0;
        if (hipGetDevice(&dev) != hipSuccess || hipDeviceGetAttribute(&cus, hipDeviceAttributeMultiprocessorCount, dev) != hipSuccess) { grid = -1; return; }
        if (hipFuncSetAttribute((const void*)mk_fwd, hipFuncAttributeMaxDynamicSharedMemorySize, LDS_BYTES) != hipSuccess) { fprintf(stderr, "kernel_launch: hipFuncSetAttribute failed\n"); grid = -1; return; }
        if (hipOccupancyMaxActiveBlocksPerMultiprocessor(&per_cu, (const void*)mk_fwd, 512, LDS_BYTES) != hipSuccess || per_cu < 1) fprintf(stderr, "kernel_launch: occupancy query says %d\n", per_cu);
        (void)hipGetLastError();
        grid = cus;
    }
    if (grid < 0) return;
    if (hipMemsetAsync((char*)d_ws + WS_CTL, 0, CTL_ZERO_BYTES, stream) != hipSuccess) return;
    Args a{};
    for (int i = 0; i < 31; ++i) a.in[i] = (const float*)d_in[i];
    a.out = (float*)d_out; a.ws = (unsigned char*)d_ws; a.pad = 0;
    for (int li = 0; li < MK_N_LAUNCHES + (DBG_DUMP ? 1 : 0); ++li) {
        if (li > DBG_STOP && li < NPHASE) continue;
        a.ph_lo = (MK_N_LAUNCHES == NPHASE) ? li : 0; a.ph_hi = (MK_N_LAUNCHES == NPHASE) ? li + 1 : NPHASE; a.li = 0;
        hipLaunchKernelGGL(mk_fwd, dim3(grid), dim3(512), LDS_BYTES, stream, a);
        const hipError_t le = hipPeekAtLastError();
        if (le != hipSuccess) { fprintf(stderr, "kernel_launch: launch %d failed: %s\n", li, hipGetErrorName(le)); break; }
    }
}
```
